# Optimizing an MI355X kernel written in HIP

```python
import math
import jax
import jax.numpy as jnp
from jax import lax
import numpy as np

D_MODEL = 2048
BATCH = 8
SEQ = 4096
DEPTH = 1
DEC_BATCH = 1
DEC_SEQ = 16384
PAST_LEN = 128

RW_HEADS = 16
RW_HEAD_DIM = 64
RW_WIDTH = RW_HEADS * RW_HEAD_DIM
RW_DECAY_LORA = 64
RW_AAA_LORA = 64
RW_GATE_LORA = 128
GD_HEADS = 8
GD_HEAD_DIM = 128
GD_WIDTH = GD_HEADS * GD_HEAD_DIM
GD_CONV = 3
GD_CHUNK = 64
MIX_WIDTH = RW_WIDTH + GD_WIDTH
D_FF = 5632
FFN_CONV = 3
LN_EPS = 1e-5
GN_EPS = 64e-5
RMS_EPS = 1e-6
L2_EPS = 1e-6
DN_ALPHA = (2.0 * DEPTH) ** 0.25
DN_BETA = (8.0 * DEPTH) ** -0.25
RW_SIZES = (RW_WIDTH, RW_WIDTH, RW_WIDTH, RW_DECAY_LORA, RW_DECAY_LORA, RW_AAA_LORA, RW_GATE_LORA)
GD_SIZES = (3 * GD_WIDTH, GD_WIDTH, GD_HEADS, GD_HEADS, GD_HEADS)
RW_COLS = sum(RW_SIZES)
GD_COLS = sum(GD_SIZES)
IN_COLS = RW_COLS + GD_COLS

kernel_name = "hybrid_rwkv7_gdn_bidir_encoder"


def _split(t, sizes):
    out, start = [], 0
    for s in sizes:
        out.append(t[..., start:start + s])
        start += s
    return out


def _flip(t):
    return jnp.flip(t, axis=1)


def _layer_norm(x, g, b):
    xf = x.astype(jnp.float32)
    mu = jnp.mean(xf, axis=-1, keepdims=True)
    var = jnp.mean(jnp.square(xf - mu), axis=-1, keepdims=True)
    return ((xf - mu) * lax.rsqrt(var + LN_EPS) * g + b).astype(x.dtype)


def _l2norm(t):
    return t * lax.rsqrt(jnp.sum(jnp.square(t), axis=-1, keepdims=True) + L2_EPS)


def _dwconv_centred(x, w):
    width = w.shape[0]
    half = width // 2
    T = x.shape[1]
    xp = jnp.pad(x, ((0, 0), (half, half), (0, 0)))
    y = xp[:, 0:T] * w[0]
    for i in range(1, width):
        y = y + xp[:, i:i + T] * w[i]
    return y


def _token_shift(p, mu_prev, mu_next):
    prev = jnp.pad(p, ((0, 0), (1, 0), (0, 0)))[:, :-1]
    nxt = jnp.pad(p, ((0, 0), (0, 1), (0, 0)))[:, 1:]
    return p + mu_prev * (prev - p) + mu_next * (nxt - p)


def _rwkv7_scan(r, w, k, v, kk, a):
    B, T, H, N = r.shape

    def step(S, inp):
        r_t, w_t, k_t, v_t, kk_t, a_t = inp
        sa = jnp.einsum('bhvk,bhk->bhv', S, -kk_t)
        S = (S * w_t[:, :, None, :]
             + sa[..., None] * (kk_t * a_t)[:, :, None, :]
             + v_t[..., None] * k_t[:, :, None, :])
        return S, jnp.einsum('bhvk,bhk->bhv', S, r_t)

    S0 = jnp.zeros((B, H, N, N), jnp.float32)
    xs = tuple(jnp.moveaxis(t, 1, 0) for t in (r, w, k, v, kk, a))
    _, o = lax.scan(step, S0, xs)
    return jnp.moveaxis(o, 0, 1)


def _rwkv_decay(lo, w0, up):
    wl = -jax.nn.softplus(-(w0 + jnp.tanh(lo) @ up)) - 0.5
    return jnp.exp(-jnp.exp(wl))


def _rwkv7_mixer(p, mu_prev, mu_next, w0, w_up, a0, a_up, g_up, k_k, k_a, r_k, gn_w, gn_b):
    B, T, _ = p.shape
    p = _token_shift(p.astype(jnp.float32), mu_prev, mu_next)
    r, k, v, lo_wf, lo_wb, lo_a, lo_g = _split(p, RW_SIZES)
    w_f = _rwkv_decay(lo_wf, w0[0], w_up[0])
    w_b = _rwkv_decay(lo_wb, w0[1], w_up[1])
    a = jax.nn.sigmoid(a0 + lo_a @ a_up)
    g = jax.nn.sigmoid(lo_g) @ g_up
    heads = lambda t: t.reshape(B, T, RW_HEADS, RW_HEAD_DIM)
    kk = _l2norm(heads(k * k_k))
    k = k * (1.0 + (a - 1.0) * k_a)
    r, k, v, a, w_f, w_b = (heads(t) for t in (r, k, v, a, w_f, w_b))
    o = (_rwkv7_scan(r, w_f, k, v, kk, a)
         + _flip(_rwkv7_scan(_flip(r), _flip(w_b), _flip(k), _flip(v), _flip(kk), _flip(a))))
    mu = jnp.mean(o, axis=-1, keepdims=True)
    var = jnp.mean(jnp.square(o - mu), axis=-1, keepdims=True)
    o = ((o - mu) * lax.rsqrt(var + GN_EPS)).reshape(B, T, RW_WIDTH) * gn_w + gn_b
    bonus = (jnp.sum(r * k * r_k, axis=-1, keepdims=True) * v).reshape(B, T, RW_WIDTH)
    return (o + bonus) * g


def _gated_delta_chunked(q, k, v, beta, g):
    B, T, H, DK = q.shape
    DV = v.shape[-1]
    C = GD_CHUNK
    n = T // C
    ch4 = lambda t: jnp.transpose(t.reshape(B, n, C, H, t.shape[-1]), (0, 3, 1, 2, 4))
    ch3 = lambda t: jnp.transpose(t.reshape(B, n, C, H), (0, 3, 1, 2))
    q, k, v = ch4(q), ch4(k), ch4(v)
    beta, g = ch3(beta), ch3(g)
    gc = jnp.cumsum(g, axis=-1)
    tri = jnp.tril(jnp.ones((C, C), bool))
    strict = jnp.tril(jnp.ones((C, C), bool), -1)
    decay_mat = jnp.exp(jnp.where(tri, gc[..., :, None] - gc[..., None, :], -jnp.inf))
    k_beta = k * beta[..., None]
    A = jnp.where(strict, jnp.einsum('bhncd,bhnsd->bhncs', k_beta, k) * decay_mat, 0.0)
    eye = jnp.eye(C, dtype=A.dtype)
    Tm = lax.linalg.triangular_solve(eye + A, jnp.broadcast_to(eye, A.shape),
                                     left_side=True, lower=True, unit_diagonal=True)
    u = Tm @ (v * beta[..., None])
    w = Tm @ (k_beta * jnp.exp(gc)[..., None])
    qk = jnp.where(tri, jnp.einsum('bhncd,bhnsd->bhncs', q, k) * decay_mat, 0.0)
    g_last = gc[..., -1]
    k_tail = k * jnp.exp(g_last[..., None] - gc)[..., None]
    q_dec = q * jnp.exp(gc)[..., None]

    def step(S, inp):
        u_c, w_c, qd_c, qk_c, kt_c, gl_c = inp
        v_new = u_c - w_c @ S
        o = qd_c @ S + qk_c @ v_new
        S = S * jnp.exp(gl_c)[..., None, None] + jnp.einsum('bhcd,bhce->bhde', kt_c, v_new)
        return S, o

    S0 = jnp.zeros((B, H, DK, DV), jnp.float32)
    xs = tuple(jnp.moveaxis(t, 2, 0) for t in (u, w, q_dec, qk, k_tail, g_last))
    _, o = lax.scan(step, S0, xs)
    return jnp.transpose(o, (1, 0, 3, 2, 4)).reshape(B, T, H, DV)


def _gdn_mixer(p, conv_w, a_log, dt_bias, norm_w):
    B, T, _ = p.shape
    p = p.astype(jnp.float32)
    qkv, z, b, a_f, a_b = _split(p, GD_SIZES)
    qkv = jax.nn.silu(_dwconv_centred(qkv, conv_w))
    heads = lambda t: t.reshape(B, T, GD_HEADS, GD_HEAD_DIM)
    q, k, v = (heads(t) for t in _split(qkv, (GD_WIDTH, GD_WIDTH, GD_WIDTH)))
    q = _l2norm(q) * (GD_HEAD_DIM ** -0.5)
    k = _l2norm(k)
    beta = jax.nn.sigmoid(b)
    g_f = -jnp.exp(a_log[0]) * jax.nn.softplus(a_f + dt_bias[0])
    g_b = -jnp.exp(a_log[1]) * jax.nn.softplus(a_b + dt_bias[1])
    o = (_gated_delta_chunked(q, k, v, beta, g_f)
         + _flip(_gated_delta_chunked(_flip(q), _flip(k), _flip(v), _flip(beta), _flip(g_b))))
    o = o * lax.rsqrt(jnp.mean(jnp.square(o), axis=-1, keepdims=True) + RMS_EPS) * norm_w
    return o.reshape(B, T, GD_WIDTH) * jax.nn.silu(z)


def _conv_ffn(h, w_up, conv_w, w_down):
    u = _dwconv_centred(h @ w_up, conv_w)
    gate, val = u[..., :D_FF], u[..., D_FF:]
    return (jax.nn.silu(gate) * val) @ w_down


def _layer(x, w_in, rw_mu_prev, rw_mu_next, rw_w0, rw_w_up, rw_a0, rw_a_up, rw_g_up,
           rw_k_k, rw_k_a, rw_r_k, rw_gn_w, rw_gn_b, gd_conv_w, gd_a_log, gd_dt_bias,
           gd_norm_w, w_out, ln1_g, ln1_b, ffn_w_up, ffn_conv_w, ffn_w_down, ln2_g, ln2_b):
    p = x @ w_in
    o_rw = _rwkv7_mixer(p[..., :RW_COLS], rw_mu_prev, rw_mu_next, rw_w0, rw_w_up, rw_a0,
                        rw_a_up, rw_g_up, rw_k_k, rw_k_a, rw_r_k, rw_gn_w, rw_gn_b)
    o_gd = _gdn_mixer(p[..., RW_COLS:], gd_conv_w, gd_a_log, gd_dt_bias, gd_norm_w)
    mixed = jnp.concatenate([o_rw, o_gd], axis=-1).astype(x.dtype) @ w_out
    h = _layer_norm(DN_ALPHA * x + mixed, ln1_g, ln1_b)
    f = _conv_ffn(h, ffn_w_up, ffn_conv_w, ffn_w_down)
    return _layer_norm(DN_ALPHA * h + f, ln2_g, ln2_b)


def setup_inputs(seed: int = 0) -> dict:
    key = jax.random.key(seed)
    ks = iter(jax.random.split(key, 32))
    nrm = lambda shape, scale: jax.random.normal(next(ks), shape, jnp.float32) * scale
    unif = lambda shape, lo, hi: jax.random.uniform(next(ks), shape, jnp.float32, lo, hi)
    L = DEPTH
    dt = jnp.exp(unif((L, 2, GD_HEADS), math.log(1e-3), math.log(1e-1)))
    return {
        "x_prompt": nrm((BATCH, SEQ, D_MODEL), 1.0),
        "x_sample": nrm((DEC_BATCH, DEC_SEQ, D_MODEL), 1.0),
        "w_in": nrm((L, D_MODEL, IN_COLS), D_MODEL ** -0.5),
        "rw_mu_prev": unif((L, RW_COLS), 0.0, 0.5),
        "rw_mu_next": unif((L, RW_COLS), 0.0, 0.5),
        "rw_w0": unif((L, 2, RW_WIDTH), -6.0, 0.0),
        "rw_w_up": nrm((L, 2, RW_DECAY_LORA, RW_WIDTH), 0.5 * RW_DECAY_LORA ** -0.5),
        "rw_a0": nrm((L, RW_WIDTH), 0.1),
        "rw_a_up": nrm((L, RW_AAA_LORA, RW_WIDTH), 0.5 * RW_AAA_LORA ** -0.5),
        "rw_g_up": nrm((L, RW_GATE_LORA, RW_WIDTH), RW_GATE_LORA ** -0.5),
        "rw_k_k": 0.85 + nrm((L, RW_WIDTH), 0.05),
        "rw_k_a": 1.0 + nrm((L, RW_WIDTH), 0.05),
        "rw_r_k": nrm((L, RW_HEADS, RW_HEAD_DIM), 0.05),
        "rw_gn_w": 1.0 + nrm((L, RW_WIDTH), 0.02),
        "rw_gn_b": nrm((L, RW_WIDTH), 0.02),
        "gd_conv_w": nrm((L, GD_CONV, 3 * GD_WIDTH), GD_CONV ** -0.5),
        "gd_a_log": jnp.log(unif((L, 2, GD_HEADS), 1.0, 16.0)),
        "gd_dt_bias": jnp.log(jnp.expm1(dt)),
        "gd_norm_w": 1.0 + nrm((L, GD_HEAD_DIM), 0.02),
        "w_out": nrm((L, MIX_WIDTH, D_MODEL), DN_BETA * MIX_WIDTH ** -0.5),
        "ln1_g": 1.0 + nrm((L, D_MODEL), 0.02),
        "ln1_b": nrm((L, D_MODEL), 0.02),
        "ffn_w_up": nrm((L, D_MODEL, 2 * D_FF), D_MODEL ** -0.5),
        "ffn_conv_w": nrm((L, FFN_CONV, 2 * D_FF), FFN_CONV ** -0.5),
        "ffn_w_down": nrm((L, D_FF, D_MODEL), DN_BETA * D_FF ** -0.5),
        "ln2_g": 1.0 + nrm((L, D_MODEL), 0.02),
        "ln2_b": nrm((L, D_MODEL), 0.02),
    }


def reference(x_prompt, x_sample, w_in, rw_mu_prev, rw_mu_next, rw_w0, rw_w_up, rw_a0,
              rw_a_up, rw_g_up, rw_k_k, rw_k_a, rw_r_k, rw_gn_w, rw_gn_b, gd_conv_w,
              gd_a_log, gd_dt_bias, gd_norm_w, w_out, ln1_g, ln1_b, ffn_w_up, ffn_conv_w,
              ffn_w_down, ln2_g, ln2_b):
    weights = (w_in, rw_mu_prev, rw_mu_next, rw_w0, rw_w_up, rw_a0, rw_a_up, rw_g_up,
               rw_k_k, rw_k_a, rw_r_k, rw_gn_w, rw_gn_b, gd_conv_w, gd_a_log, gd_dt_bias,
               gd_norm_w, w_out, ln1_g, ln1_b, ffn_w_up, ffn_conv_w, ffn_w_down, ln2_g, ln2_b)

    def encode(x):
        for layer in range(DEPTH):
            x = _layer(x, *[wt[layer] for wt in weights])
        return x

    y_prompt = encode(x_prompt)
    y_sample = encode(x_sample)
    return (y_prompt, y_sample)
```

```cpp
#include <hip/hip_runtime.h>
#include <hip/hip_cooperative_groups.h>
#include <cstdio>
namespace cg = cooperative_groups;

typedef _Float16 h16;
typedef _Float16 h16x8 __attribute__((ext_vector_type(8)));
typedef _Float16 h16x4 __attribute__((ext_vector_type(4)));
typedef float f32x4 __attribute__((ext_vector_type(4)));
typedef float f32x2 __attribute__((ext_vector_type(2)));
#define LAS __attribute__((address_space(3)))

#ifndef REP_PH
#define REP_PH -1
#endif
#ifndef REP_N
#define REP_N 2
#endif
#ifndef ONE_LAUNCH
#define ONE_LAUNCH 1
#endif

constexpr int MT = 49152, DM = 2048, INC = 7512, INCP = 7680, DFF = 5632, DFF2 = 11264, RWC = 3392;
constexpr int NPROMPT = 32768;
constexpr int LK = 384;
constexpr int GROWS = 16384;
constexpr float DN_ALPHA = 1.189207115002721f;

constexpr size_t SZ_WIN = (size_t)INCP * DM * 2, SZ_WOUT = (size_t)DM * DM * 2, SZ_WUP = (size_t)DFF2 * DM * 2, SZ_WDN = (size_t)DM * DFF * 2,
                 SZ_LORAT = (size_t)4096 * LK * 2, SZ_CTR = 16384, SZ_BONUS = (size_t)MT * 16 * 4, SZ_XH = (size_t)MT * DM * 2;
constexpr size_t OFF_WIN = 0, OFF_WOUT = OFF_WIN + SZ_WIN, OFF_WUP = OFF_WOUT + SZ_WOUT, OFF_WDN = OFF_WUP + SZ_WUP, OFF_LORAT = OFF_WDN + SZ_WDN,
                 OFF_CTR = OFF_LORAT + SZ_LORAT, OFF_BONUS = OFF_CTR + SZ_CTR, OFF_XH = OFF_BONUS + SZ_BONUS, OFF_P = OFF_XH + SZ_XH;
constexpr size_t SZ_ARR = (size_t)MT * 1024 * 2;
constexpr size_t OFF_ACT = OFF_P + (size_t)MT * DM * 4;

constexpr int LDS_GEMM = 131072;
constexpr int LDS_TOTAL = 139264 + 256;

struct Params {
    const float *xp, *xs, *w_in, *mu_prev, *mu_next, *w0, *w_up, *a0, *a_up, *g_up, *k_k, *k_a, *r_k, *gn_w, *gn_b, *gd_conv, *a_log, *dt_bias, *gd_norm,
        *w_out, *ln1g, *ln1b, *ffn_up, *ffn_conv, *ffn_dn, *ln2g, *ln2b;
    float* out;
    unsigned char* ws;
};

__device__ __forceinline__ int opaque_tid() { int t = threadIdx.x; asm volatile("" : "+v"(t)); return t; }
template <int CTRL> __device__ __forceinline__ float dpp_mov(float x) {
    return __builtin_bit_cast(float, __builtin_amdgcn_update_dpp(0, __builtin_bit_cast(int, x), CTRL, 0xF, 0xF, true));
}
__device__ __forceinline__ float red8(float x) {
    x += dpp_mov<0xB1>(x);
    x += dpp_mov<0x4E>(x);
    x += dpp_mov<0x141>(x);
    return x;
}
__device__ __forceinline__ float red16(float x) { x = red8(x); x += dpp_mov<0x140>(x); return x; }
__device__ __forceinline__ float wave_sum(float x) {
#pragma unroll
    for (int o = 32; o >= 1; o >>= 1) x += __shfl_xor(x, o, 64);
    return x;
}
__device__ __forceinline__ float sigmoidf_(float x) { return 1.0f / (1.0f + expf(-x)); }
__device__ __forceinline__ float softplusf_(float x) { return fmaxf(x, 0.f) + log1pf(expf(-fabsf(x))); }
__device__ __forceinline__ float siluf_(float x) { return x / (1.0f + expf(-x)); }
__device__ __forceinline__ float fsigmoid(float x) { return __builtin_amdgcn_rcpf(1.0f + __expf(-x)); }
__device__ __forceinline__ float fsilu(float x) { return x * fsigmoid(x); }
__device__ __forceinline__ h16x8 ldh8(const h16* p) { return *(const h16x8*)p; }
__device__ __forceinline__ h16x8 zeroh8() { h16x8 z; for (int i = 0; i < 8; ++i) z[i] = (h16)0.f; return z; }

constexpr int BM = 256, BK = 64, HALF = 128, HTB = HALF * BK * 2, NXCD = 8, WGM = 4;
__host__ __device__ __forceinline__ int lds_byte(int r, int c) { const int st = (r >> 4) * 2 + (c >> 5), rr = r & 15, cc = c & 31, ob = rr * 64 + cc * 2; return st * 1024 + (ob ^ (((ob >> 9) & 1) << 5)); }
__host__ __device__ __forceinline__ void stage_rc(int b, int& R, int& C) { const int st = b / 1024, sb = b % 1024, swz = sb ^ (((sb >> 9) & 1) << 5); R = (st >> 1) * 16 + swz / 64; C = (st & 1) * 32 + (swz % 64) / 2; }
__host__ __device__ __forceinline__ int perm32(int rho) { const int n = rho >> 4, i = rho & 15; return 8 * (i >> 2) + 4 * n + (i & 3); }

struct Unit { int pm, pn; };
struct Gemm { const h16* A; const h16* Bt; int M, N, K; const h16* A2; int ks; int lda; };
struct StaticOrder {
    int nM, nN, nwg, G, c;
    __device__ void init(int M, int N, int G_, int c_) { nM = M / BM; nN = N / BM; nwg = nM * nN; G = G_; c = c_; }
    __device__ bool next(int i, Unit& u) const {
        const long L = (long)i * G + c; if (L >= nwg) return false;
        int wgid = (int)L; { const int q = nwg / NXCD, r = nwg % NXCD, xcd = wgid % NXCD, off = wgid / NXCD; wgid = (xcd < r ? xcd * (q + 1) : r * (q + 1) + (xcd - r) * q) + off; }
        const int nig = WGM * nN, gid = wgid / nig, fm = gid * WGM, gsz = (nM - fm) < WGM ? (nM - fm) : WGM;
        u.pm = fm + ((wgid % nig) % gsz); u.pn = (wgid % nig) / gsz; return true;
    }
};

struct EpiH16 {
    static constexpr bool PERM = true;
    h16* C; int ldc; int ncols; int tiles_per_arr; size_t arr_stride;
    __device__ __forceinline__ void operator()(const f32x4 (&acc)[2][2][4][2], const Unit& u, int wr, int wc, int fr, int fq) const {
        const int arr = u.pn / tiles_per_arr, pnl = u.pn - arr * tiles_per_arr;
        h16* base = C + (size_t)arr * arr_stride;
        const int row0 = u.pm * BM + wr * 64 + fr, col0 = pnl * BM + wc * 32 + 8 * fq;
#pragma unroll
        for (int ai = 0; ai < 2; ++ai)
#pragma unroll
            for (int m = 0; m < 4; ++m) { h16* rowp = base + (size_t)(row0 + ai * HALF + m * 16) * ldc + col0;
#pragma unroll
                for (int bj = 0; bj < 2; ++bj) { const f32x4 v0 = acc[ai][bj][m][0], v1 = acc[ai][bj][m][1];
                    h16x8 w; w[0] = (h16)v0[0]; w[1] = (h16)v0[1]; w[2] = (h16)v0[2]; w[3] = (h16)v0[3]; w[4] = (h16)v1[0]; w[5] = (h16)v1[1]; w[6] = (h16)v1[2]; w[7] = (h16)v1[3];
                    if (col0 + bj * HALF < ncols) *(h16x8*)(rowp + bj * HALF) = w; } }
    }
};
struct EpiRes {
    static constexpr bool PERM = false;
    h16* out; const float* res0; const float* res1; int split_row; const h16* resh;
    __device__ __forceinline__ void operator()(const f32x4 (&acc)[2][2][4][2], const Unit& u, int wr, int wc, int fr, int fq) const {
        const int row0 = u.pm * BM + wr * 64 + fr, col0 = u.pn * BM + wc * 32 + 4 * fq;
#pragma unroll
        for (int ai = 0; ai < 2; ++ai)
#pragma unroll
            for (int m = 0; m < 4; ++m) { const int row = row0 + ai * HALF + m * 16;
                const float* rp = (row < split_row ? res0 + (size_t)row * DM : res1 + (size_t)(row - split_row) * DM) + col0;
                h16* op = out + (size_t)row * DM + col0;
#pragma unroll
                for (int bj = 0; bj < 2; ++bj)
#pragma unroll
                    for (int n = 0; n < 2; ++n) { f32x4 r;
                        if (resh) { const h16x4 hv = *(const h16x4*)(resh + (size_t)row * DM + col0 + bj * HALF + n * 16); r = (f32x4){(float)hv[0], (float)hv[1], (float)hv[2], (float)hv[3]}; }
                        else r = *(const f32x4*)(rp + bj * HALF + n * 16);
                        const f32x4 y = r * DN_ALPHA + acc[ai][bj][m][n]; h16x4 hy; hy[0] = (h16)y[0]; hy[1] = (h16)y[1]; hy[2] = (h16)y[2]; hy[3] = (h16)y[3];
                        *(h16x4*)(op + bj * HALF + n * 16) = hy; } }
    }
};

template <class Epi>
__device__ __forceinline__ void gemm_phase(LAS unsigned char* lds, const Gemm g, const StaticOrder& S, const Epi& E) {
    const int tid = opaque_tid(), wid = __builtin_amdgcn_readfirstlane(tid >> 6), lane = tid & 63, wr = wid >> 2, wc = wid & 3, fr = lane & 15, fq = lane >> 4;
    const int K = g.K, nt = K / BK;
    unsigned voffA[2], voffB[2];
#pragma unroll
    for (int i = 0; i < 2; ++i) { int R, C; stage_rc(tid * 16 + i * 8192, R, C); const int Rb = Epi::PERM ? ((R & ~31) + perm32(R & 31)) : R;
        voffA[i] = (unsigned)(R * g.lda + C) * 2u; voffB[i] = (unsigned)(Rb * K + C) * 2u; }
    const size_t kstep = (size_t)(BK * 2);
    const size_t hstep = (size_t)HALF * K * 2;
    const size_t tstep = 2 * hstep;
    const size_t hstepA = (size_t)HALF * g.lda * 2, tstepA = 2 * hstepA; const int ks = g.ks;
#define APTR(b1, b2, t) ((t) < ks ? (b1) + (size_t)(t) * kstep : (b2) + (size_t)((t) - ks) * kstep)
    const unsigned ldsw = (unsigned)wid * 1024u;
    const int aoff = lds_byte(wr * 64 + fr, fq * 8), boff = lds_byte(wc * 32 + fr, fq * 8);
#define PG8_SA(b, h) (((b) * 2 + (h)) * HTB)
#define PG8_SB(b, h) ((4 + (b) * 2 + (h)) * HTB)
#define PG8_STAGE(bufoff, gbase, voff) do { _Pragma("unroll") for (int _i = 0; _i < 2; ++_i) \
        __builtin_amdgcn_global_load_lds((const unsigned*)((const char*)(gbase) + (voff)[_i]), (LAS unsigned*)(lds + (bufoff) + ldsw + _i * 8192), 16, 0, 0); } while (0)
#define PG8_LDA(dst, b, h) do { _Pragma("unroll") for (int m = 0; m < 4; ++m) _Pragma("unroll") for (int k = 0; k < 2; ++k) dst[m][k] = *(const LAS h16x8*)(lds + PG8_SA(b, h) + aoff + m * 2048 + k * 1024); } while (0)
#define PG8_LDB(dst, b, h) do { _Pragma("unroll") for (int n = 0; n < 2; ++n) _Pragma("unroll") for (int k = 0; k < 2; ++k) dst[n][k] = *(const LAS h16x8*)(lds + PG8_SB(b, h) + boff + n * 2048 + k * 1024); } while (0)
#define PG8_MMA(ai, bj, At, Bt) do { __builtin_amdgcn_s_setprio(1); _Pragma("unroll") for (int m = 0; m < 4; ++m) _Pragma("unroll") for (int n = 0; n < 2; ++n) _Pragma("unroll") for (int k = 0; k < 2; ++k) \
        acc[ai][bj][m][n] = __builtin_amdgcn_mfma_f32_16x16x32_f16(Bt[n][k], At[m][k], acc[ai][bj][m][n], 0, 0, 0); __builtin_amdgcn_s_setprio(0); } while (0)
#define PG8_WAIT_V(n) asm volatile("s_waitcnt vmcnt(" #n ")" ::: "memory")
#define PG8_WAIT_L(n) asm volatile("s_waitcnt lgkmcnt(" #n ")" ::: "memory")
#define PG8_BAR __builtin_amdgcn_s_barrier()
#define PG8_SCHED __builtin_amdgcn_sched_barrier(0)
    Unit cur, nxt; int ui = 0;
    if (!S.next(0, cur)) return;
    f32x4 acc[2][2][4][2];
#pragma unroll
    for (int a = 0; a < 2; ++a)
#pragma unroll
        for (int b = 0; b < 2; ++b)
#pragma unroll
            for (int m = 0; m < 4; ++m)
#pragma unroll
                for (int n = 0; n < 2; ++n) acc[a][b][m][n] = (f32x4){0.f, 0.f, 0.f, 0.f};
    h16x8 At[4][2], B0[2][2], B1[2][2];
    const char* cA = (const char*)g.A + (size_t)cur.pm * tstepA; const char* cA2 = (const char*)g.A2 + (size_t)cur.pm * tstepA; const char* cB = (const char*)g.Bt + (size_t)cur.pn * tstep;
    PG8_STAGE(PG8_SB(0, 0), cB, voffB); PG8_STAGE(PG8_SA(0, 0), cA, voffA); PG8_STAGE(PG8_SB(0, 1), cB + hstep, voffB); PG8_STAGE(PG8_SA(0, 1), cA + hstepA, voffA);
    if (wr == 1) PG8_BAR;
    PG8_WAIT_V(4); PG8_BAR;
    PG8_STAGE(PG8_SB(1, 0), cB + kstep, voffB); PG8_STAGE(PG8_SA(1, 0), cA + kstep, voffA); PG8_STAGE(PG8_SB(1, 1), cB + hstep + kstep, voffB);
    PG8_WAIT_V(6); PG8_BAR;
    for (;;) {
        const bool has_next = S.next(ui + 1, nxt);
        const char* nA = has_next ? (const char*)g.A + (size_t)nxt.pm * tstepA : cA; const char* nA2 = has_next ? (const char*)g.A2 + (size_t)nxt.pm * tstepA : cA2; const char* nB = has_next ? (const char*)g.Bt + (size_t)nxt.pn * tstep : cB;
        for (int t = 0; t < nt; t += 2) {
            const bool last = (t == nt - 2);
            const char* a1 = APTR(cA, cA2, t + 1);
            const char* a2 = last ? nA : APTR(cA, cA2, t + 2); const char* b2 = last ? nB : cB + (size_t)(t + 2) * kstep;
            const char* a3 = a2 + kstep; const char* b3 = b2 + kstep;
            PG8_LDB(B0, 0, 0); PG8_SCHED; PG8_LDA(At, 0, 0); PG8_STAGE(PG8_SA(1, 1), a1 + hstepA, voffA);
            PG8_WAIT_L(8); PG8_BAR; PG8_WAIT_L(0); PG8_MMA(0, 0, At, B0); PG8_BAR; PG8_SCHED;
            PG8_LDB(B1, 0, 1); PG8_STAGE(PG8_SB(0, 0), b2, voffB);
            PG8_BAR; PG8_WAIT_L(0); PG8_MMA(0, 1, At, B1); PG8_BAR;
            PG8_LDA(At, 0, 1); PG8_STAGE(PG8_SA(0, 0), a2, voffA);
            PG8_BAR; PG8_WAIT_L(0); PG8_MMA(1, 0, At, B0); PG8_BAR; PG8_SCHED;
            PG8_STAGE(PG8_SB(0, 1), b2 + hstep, voffB);
            PG8_WAIT_V(6); PG8_BAR; PG8_MMA(1, 1, At, B1); PG8_BAR;
            PG8_LDB(B0, 1, 0); PG8_SCHED; PG8_LDA(At, 1, 0); PG8_STAGE(PG8_SA(0, 1), a2 + hstepA, voffA);
            PG8_WAIT_L(8); PG8_BAR; PG8_WAIT_L(0); PG8_MMA(0, 0, At, B0); PG8_BAR; PG8_SCHED;
            PG8_LDB(B1, 1, 1); PG8_STAGE(PG8_SB(1, 0), b3, voffB);
            PG8_BAR; PG8_WAIT_L(0); PG8_MMA(0, 1, At, B1); PG8_BAR;
            PG8_LDA(At, 1, 1); PG8_STAGE(PG8_SA(1, 0), a3, voffA);
            PG8_BAR; PG8_WAIT_L(0); PG8_MMA(1, 0, At, B0); PG8_BAR; PG8_SCHED;
            PG8_STAGE(PG8_SB(1, 1), b3 + hstep, voffB);
            PG8_WAIT_V(6); PG8_BAR; PG8_MMA(1, 1, At, B1); PG8_BAR;
        }
        E(acc, cur, wr, wc, fr, fq);
        if (!has_next) break;
#pragma unroll
        for (int a = 0; a < 2; ++a)
#pragma unroll
            for (int b = 0; b < 2; ++b)
#pragma unroll
                for (int m = 0; m < 4; ++m)
#pragma unroll
                    for (int n = 0; n < 2; ++n) acc[a][b][m][n] = (f32x4){0.f, 0.f, 0.f, 0.f};
        cur = nxt; cA = nA; cA2 = nA2; cB = nB; ++ui;
    }
    PG8_WAIT_V(0);
    if (wr == 0) PG8_BAR;
    PG8_BAR;
#undef APTR
#undef PG8_SA
#undef PG8_SB
#undef PG8_STAGE
#undef PG8_LDA
#undef PG8_LDB
#undef PG8_MMA
#undef PG8_WAIT_V
#undef PG8_WAIT_L
#undef PG8_BAR
#undef PG8_SCHED
}

__device__ void transpose_tile(const float* __restrict__ src, int N, h16* __restrict__ dst, int K, int k0, int n0, LAS float* lds) {
    const int tid = opaque_tid();
#pragma unroll
    for (int i = 0; i < 8; ++i) { const int k = (tid >> 6) + 8 * i, n = tid & 63; lds[k * 65 + n] = (n0 + n < N) ? src[(size_t)(k0 + k) * N + n0 + n] : 0.f; }
    __syncthreads();
    { const int n = tid >> 3, kk0 = (tid & 7) * 8; h16x8 v;
#pragma unroll
      for (int e = 0; e < 8; ++e) v[e] = (h16)lds[(kk0 + e) * 65 + n];
      *(h16x8*)(dst + (size_t)(n0 + n) * K + k0 + kk0) = v; }
    __syncthreads();
}
__device__ void phase_convert(const Params& p, LAS unsigned char* shm, const int part) {
    const int tid = opaque_tid(), nb = gridDim.x, b = blockIdx.x;
    unsigned char* ws = p.ws;
    if (part == 0 && b == 0 && tid < 64) ((unsigned*)(ws + OFF_CTR))[tid] = 0u;
    if (part == 0) { h16* XH = (h16*)(ws + OFF_XH); const size_t nvec = (size_t)MT * DM / 8, stride = (size_t)nb * 512;
      for (size_t i0 = (size_t)b * 512 + tid; i0 < nvec; i0 += 4 * stride) {
          f32x4 a[4], bq[4];
#pragma unroll
          for (int u = 0; u < 4; ++u) { const size_t i = i0 + u * stride; const size_t m = i >> 8; const int c = (int)(i & 255) * 8;
              const float* sp = (m < NPROMPT ? p.xp + m * DM : p.xs + (m - NPROMPT) * DM) + c; if (i < nvec) { a[u] = *(const f32x4*)sp; bq[u] = *(const f32x4*)(sp + 4); } }
#pragma unroll
          for (int u = 0; u < 4; ++u) { const size_t i = i0 + u * stride; const size_t m = i >> 8; const int c = (int)(i & 255) * 8;
              h16x8 v; v[0] = (h16)a[u][0]; v[1] = (h16)a[u][1]; v[2] = (h16)a[u][2]; v[3] = (h16)a[u][3]; v[4] = (h16)bq[u][0]; v[5] = (h16)bq[u][1]; v[6] = (h16)bq[u][2]; v[7] = (h16)bq[u][3];
              if (i < nvec) *(h16x8*)(XH + m * DM + c) = v; } } }
    { LAS float* lds = (LAS float*)shm;
      const int t_in = 32 * 118, t_out = 32 * 32, t_up = 32 * 176, t_dn = 88 * 32, tot = t_in + t_out + t_up + t_dn;
      const int tlo = part == 0 ? 0 : t_in + t_out, thi = part == 0 ? t_in + t_out : tot;
      struct TD { const float* src; h16* dst; int N, K, k0, n0; };
      auto desc = [&](int t) { TD d;
          if (t < t_in) { d.src = p.w_in; d.N = INC; d.dst = (h16*)(ws + OFF_WIN); d.K = DM; d.k0 = (t % 32) * 64; d.n0 = (t / 32) * 64; }
          else if (t < t_in + t_out) { const int u = t - t_in; d.src = p.w_out; d.N = DM; d.dst = (h16*)(ws + OFF_WOUT); d.K = DM; d.k0 = (u % 32) * 64; d.n0 = (u / 32) * 64; }
          else if (t < t_in + t_out + t_up) { const int u = t - t_in - t_out; d.src = p.ffn_up; d.N = DFF2; d.dst = (h16*)(ws + OFF_WUP); d.K = DM; d.k0 = (u % 32) * 64; d.n0 = (u / 32) * 64; }
          else { const int u = t - t_in - t_out - t_up; d.src = p.ffn_dn; d.N = DM; d.dst = (h16*)(ws + OFF_WDN); d.K = DFF; d.k0 = (u % 88) * 64; d.n0 = (u / 88) * 64; }
          return d; };
      auto ldtile = [&](const TD& d, float (&r)[8]) {
#pragma unroll
          for (int i = 0; i < 8; ++i) { const int k = (tid >> 6) + 8 * i, n = tid & 63; r[i] = (d.n0 + n < d.N) ? d.src[(size_t)(d.k0 + k) * d.N + d.n0 + n] : 0.f; } };
      int t = tlo + b;
      if (t < thi) {
          TD dc = desc(t); float cur[8]; ldtile(dc, cur);
          for (;;) {
              const int tn = t + nb; const bool more = tn < thi; TD dn = dc; float nxt[8];
#pragma unroll
              for (int i = 0; i < 8; ++i) nxt[i] = 0.f;
              if (more) { dn = desc(tn); ldtile(dn, nxt); }
#pragma unroll
              for (int i = 0; i < 8; ++i) lds[((tid >> 6) + 8 * i) * 65 + (tid & 63)] = cur[i];
              __syncthreads();
              { const int n = tid >> 3, kk0 = (tid & 7) * 8; h16x8 v;
#pragma unroll
                for (int e = 0; e < 8; ++e) v[e] = (h16)lds[(kk0 + e) * 65 + n];
                *(h16x8*)(dc.dst + (size_t)(dc.n0 + n) * dc.K + dc.k0 + kk0) = v; }
              __syncthreads();
              if (!more) break;
              dc = dn; t = tn;
#pragma unroll
              for (int i = 0; i < 8; ++i) cur[i] = nxt[i];
          }
      } }
    if (part == 0) { h16* LT = (h16*)(ws + OFF_LORAT);
      for (int i = b * 512 + tid; i < 4096 * 256; i += nb * 512) { const int n = i >> 8, k = i & 255; float v = 0.f;
          if (n < 3072) { const int blk = n >> 10, nn = n & 1023;
              if (blk == 0) { if (k < 64) v = p.w_up[(size_t)k * 1024 + nn]; }
              else if (blk == 1) { if (k >= 64 && k < 128) v = p.w_up[(size_t)k * 1024 + nn]; }
              else { if (k >= 128 && k < 192) v = p.a_up[(size_t)(k - 128) * 1024 + nn]; } }
          else { if (k < 128) v = p.g_up[(size_t)k * 1024 + (n - 3072)]; }
          LT[i] = (h16)v; } }
}

__device__ void phase_lora_prep(const Params& p) {
    const h16* P = (const h16*)(p.ws + OFF_P); h16* LIN = (h16*)(p.ws + OFF_XH);
    const int nvec = MT * 64;
    const int tid = opaque_tid();
    for (int i = blockIdx.x * 512 + tid; i < nvec; i += gridDim.x * 512) {
        const int m = i >> 6, c = (i & 63) * 8;
        h16x8 o = zeroh8();
        const bool act = c < 192 || (c >= 256 && c < 384);
        if (act) {
            const int T = m < NPROMPT ? 4096 : 16384, t = m < NPROMPT ? (m & 4095) : (m - NPROMPT);
            const int col = c < 192 ? 3072 + c : 3008 + c; const h16* pc = P + (size_t)m * INC + col;
            const h16x8 xc = ldh8(pc), xpv = t > 0 ? ldh8(pc - INC) : zeroh8(), xn = t < T - 1 ? ldh8(pc + INC) : zeroh8();
#pragma unroll
            for (int e = 0; e < 8; ++e) { const float mp = p.mu_prev[col + e], mn = p.mu_next[col + e]; const float x = (float)xc[e];
                const float sv = x + mp * ((float)xpv[e] - x) + mn * ((float)xn[e] - x);
                float r; if (c < 128) r = 2.0f * fsigmoid(2.0f * sv) - 1.0f; else if (c < 192) r = sv; else r = fsigmoid(sv);
                o[e] = (h16)r; }
        }
        *(h16x8*)(LIN + (size_t)m * 512 + c) = o;
    }
}

constexpr int TT = 32;
constexpr int RW_STRIDE = 388, RW_INF = TT * RW_STRIDE, RW_OUTF = TT * 64;
template <int R>
__device__ __forceinline__ void rw_task(const Params& p, LAS unsigned char* shm, const int tid, const int s, const int d, const int h, const int half) {
    LAS float* inb = (LAS float*)shm; LAS float* outb = inb + 2 * RW_INF;
    const h16* P = (const h16*)(p.ws + OFF_P);
    h16* LOR = (h16*)p.out;
    float* BONUS = (float*)(p.ws + OFF_BONUS);
    {
        const int T = s < 8 ? 4096 : 16384, base = s < 8 ? s * 4096 : NPROMPT, ntiles = T / TT;
        const h16* LW = LOR + (size_t)d * (SZ_ARR / 2); const h16* LA = LOR + (size_t)2 * (SZ_ARR / 2);
        h16* OD = R == 2 ? LOR + (size_t)d * (SZ_ARR / 2) + (size_t)base * 1024 : (h16*)(p.ws + OFF_WUP) + (size_t)d * ((size_t)16384 * 1024);
        if (__builtin_amdgcn_readfirstlane(tid >> 6) < 4) {
            const int w = tid >> 6, l = tid & 63, j = l & 7, rs = l >> 3; const int row0 = R == 2 ? w * 16 + rs : half * 32 + w * 8 + rs, row1 = row0 + 8;
            f32x2 s0[4], s1[4];
#pragma unroll
            for (int e = 0; e < 4; ++e) { s0[e] = (f32x2){0.f, 0.f}; s1[e] = (f32x2){0.f, 0.f}; }
            __syncthreads();
            for (int ti = 0; ti < ntiles; ++ti) {
                const LAS float* ib = inb + (ti & 1) * RW_INF; LAS float* ob = outb + (ti & 1) * RW_OUTF;
                LAS float* ow0 = j == 0 ? ob + row0 : outb + 2 * RW_OUTF + l; LAS float* ow1 = j == 0 ? ob + row1 : outb + 2 * RW_OUTF + 64 + l; const int omask = j == 0 ? -1 : 0;
#pragma unroll 2
                for (int st = 0; st < TT; ++st) {
                    const LAS float* sb = ib + st * RW_STRIDE;
                    f32x2 ww[4], kk[4], bb[4], kc[4], wr[4];
                    { const f32x4 a = *(const LAS f32x4*)(sb + 8 * j), b = *(const LAS f32x4*)(sb + 8 * j + 4); ww[0] = (f32x2){a[0], a[1]}; ww[1] = (f32x2){a[2], a[3]}; ww[2] = (f32x2){b[0], b[1]}; ww[3] = (f32x2){b[2], b[3]}; }
                    { const f32x4 a = *(const LAS f32x4*)(sb + 64 + 8 * j), b = *(const LAS f32x4*)(sb + 64 + 8 * j + 4); kk[0] = (f32x2){a[0], a[1]}; kk[1] = (f32x2){a[2], a[3]}; kk[2] = (f32x2){b[0], b[1]}; kk[3] = (f32x2){b[2], b[3]}; }
                    { const f32x4 a = *(const LAS f32x4*)(sb + 128 + 8 * j), b = *(const LAS f32x4*)(sb + 128 + 8 * j + 4); bb[0] = (f32x2){a[0], a[1]}; bb[1] = (f32x2){a[2], a[3]}; bb[2] = (f32x2){b[0], b[1]}; bb[3] = (f32x2){b[2], b[3]}; }
                    { const f32x4 a = *(const LAS f32x4*)(sb + 192 + 8 * j), b = *(const LAS f32x4*)(sb + 192 + 8 * j + 4); kc[0] = (f32x2){a[0], a[1]}; kc[1] = (f32x2){a[2], a[3]}; kc[2] = (f32x2){b[0], b[1]}; kc[3] = (f32x2){b[2], b[3]}; }
                    { const f32x4 a = *(const LAS f32x4*)(sb + 256 + 8 * j), b = *(const LAS f32x4*)(sb + 256 + 8 * j + 4); wr[0] = (f32x2){a[0], a[1]}; wr[1] = (f32x2){a[2], a[3]}; wr[2] = (f32x2){b[0], b[1]}; wr[3] = (f32x2){b[2], b[3]}; }
                    const float v0 = sb[320 + row0], v1 = R == 2 ? sb[320 + row1] : 0.f; const f32x2 sc = *(const LAS f32x2*)(sb + 384); const float br = sc[0], kr = sc[1];
                    if constexpr (R == 2) {
                    f32x2 pa0 = s0[0] * kk[0], px0 = s0[0] * wr[0], pa1 = s1[0] * kk[0], px1 = s1[0] * wr[0];
#pragma unroll
                    for (int e = 1; e < 4; ++e) { pa0 += s0[e] * kk[e]; px0 += s0[e] * wr[e]; pa1 += s1[e] * kk[e]; px1 += s1[e] * wr[e]; }
                    const float sa0 = red8(pa0[0] + pa0[1]), x0 = red8(px0[0] + px0[1]), sa1 = red8(pa1[0] + pa1[1]), x1 = red8(px1[0] + px1[1]);
                    const float o0 = x0 - sa0 * br + v0 * kr, o1 = x1 - sa1 * br + v1 * kr;
                    const f32x2 nsa0 = (f32x2){-sa0, -sa0}, nsa1 = (f32x2){-sa1, -sa1}, vv0 = (f32x2){v0, v0}, vv1 = (f32x2){v1, v1};
#pragma unroll
                    for (int e = 0; e < 4; ++e) { s0[e] = s0[e] * ww[e] + nsa0 * bb[e] + vv0 * kc[e]; s1[e] = s1[e] * ww[e] + nsa1 * bb[e] + vv1 * kc[e]; }
                    ow0[(st * 64) & omask] = o0; ow1[(st * 64) & omask] = o1;
                    } else {
                    f32x2 pa0 = s0[0] * kk[0], px0 = s0[0] * wr[0], pa1 = s0[1] * kk[1], px1 = s0[1] * wr[1];
                    pa0 += s0[2] * kk[2]; px0 += s0[2] * wr[2]; pa1 += s0[3] * kk[3]; px1 += s0[3] * wr[3];
                    pa0 += pa1; px0 += px1;
                    const float sa0 = red8(pa0[0] + pa0[1]), x0 = red8(px0[0] + px0[1]);
                    const float o0 = x0 - sa0 * br + v0 * kr;
                    const f32x2 nsa0 = (f32x2){-sa0, -sa0}, vv0 = (f32x2){v0, v0};
#pragma unroll
                    for (int e = 0; e < 4; ++e) s0[e] = s0[e] * ww[e] + nsa0 * bb[e] + vv0 * kc[e];
                    ow0[(st * 64) & omask] = o0; (void)ow1;
                    (void)v1; (void)row1;
                    }
                }
                __syncthreads();
            }
        } else {
            const int lt = tid - 256, st = lt >> 3, c0 = (lt & 7) * 8, hc = h * 64 + c0;
            float mpr[8], mnr[8], mpk[8], mnk[8], mpv[8], mnv[8], w0v[8], a0v[8], kkv[8], kav[8], rkv[8];
#pragma unroll
            for (int e = 0; e < 8; ++e) { mpr[e] = p.mu_prev[hc + e]; mnr[e] = p.mu_next[hc + e]; mpk[e] = p.mu_prev[1024 + hc + e]; mnk[e] = p.mu_next[1024 + hc + e];
                mpv[e] = p.mu_prev[2048 + hc + e]; mnv[e] = p.mu_next[2048 + hc + e]; w0v[e] = p.w0[d * 1024 + hc + e]; a0v[e] = p.a0[hc + e]; kkv[e] = p.k_k[hc + e]; kav[e] = p.k_a[hc + e]; rkv[e] = p.r_k[hc + e]; }
            for (int ti = 0; ti <= ntiles; ++ti) {
                if (ti < ntiles) {
                    const int js = ti * TT + st, t = d ? T - 1 - js : js; const size_t m = (size_t)base + t;
                    const h16* pr = P + m * INC + hc; const bool hp = t > 0, hn = t < T - 1;
                    const h16x8 rc = ldh8(pr), rp = hp ? ldh8(pr - INC) : zeroh8(), rn = hn ? ldh8(pr + INC) : zeroh8();
                    const h16x8 kc = ldh8(pr + 1024), kp_ = hp ? ldh8(pr + 1024 - INC) : zeroh8(), kn = hn ? ldh8(pr + 1024 + INC) : zeroh8();
                    const h16x8 vc = ldh8(pr + 2048), vp = hp ? ldh8(pr + 2048 - INC) : zeroh8(), vn = hn ? ldh8(pr + 2048 + INC) : zeroh8();
                    const h16x8 wl = ldh8(LW + m * 1024 + hc), al = ldh8(LA + m * 1024 + hc);
                    float r[8], k[8], v[8], wd[8], a[8], kkr[8]; float nrm = 0.f;
#pragma unroll
                    for (int e = 0; e < 8; ++e) { const float x = (float)rc[e]; r[e] = x + mpr[e] * ((float)rp[e] - x) + mnr[e] * ((float)rn[e] - x);
                        const float y = (float)kc[e]; k[e] = y + mpk[e] * ((float)kp_[e] - y) + mnk[e] * ((float)kn[e] - y);
                        const float z = (float)vc[e]; v[e] = z + mpv[e] * ((float)vp[e] - z) + mnv[e] * ((float)vn[e] - z);
                        const float wpre = w0v[e] + (float)wl[e]; wd[e] = __expf(-0.6065306597126334f * fsigmoid(wpre));
                        a[e] = fsigmoid(a0v[e] + (float)al[e]); kkr[e] = k[e] * kkv[e]; nrm += kkr[e] * kkr[e]; }
                    nrm = red8(nrm); const float rinv = rsqrtf(nrm + 1e-6f);
                    float br = 0.f, kr = 0.f, bon = 0.f; float kk[8], bb[8], kp[8], wr[8];
#pragma unroll
                    for (int e = 0; e < 8; ++e) { kk[e] = kkr[e] * rinv; bb[e] = kk[e] * a[e]; kp[e] = k[e] * (1.f + (a[e] - 1.f) * kav[e]); wr[e] = wd[e] * r[e];
                        br += bb[e] * r[e]; kr += kp[e] * r[e]; bon += r[e] * kp[e] * rkv[e]; }
                    br = red8(br); kr = red8(kr); bon = red8(bon);
                    LAS float* sb = inb + (ti & 1) * RW_INF + st * RW_STRIDE;
                    *(LAS f32x4*)(sb + c0) = (f32x4){wd[0], wd[1], wd[2], wd[3]}; *(LAS f32x4*)(sb + c0 + 4) = (f32x4){wd[4], wd[5], wd[6], wd[7]};
                    *(LAS f32x4*)(sb + 64 + c0) = (f32x4){kk[0], kk[1], kk[2], kk[3]}; *(LAS f32x4*)(sb + 64 + c0 + 4) = (f32x4){kk[4], kk[5], kk[6], kk[7]};
                    *(LAS f32x4*)(sb + 128 + c0) = (f32x4){bb[0], bb[1], bb[2], bb[3]}; *(LAS f32x4*)(sb + 128 + c0 + 4) = (f32x4){bb[4], bb[5], bb[6], bb[7]};
                    *(LAS f32x4*)(sb + 192 + c0) = (f32x4){kp[0], kp[1], kp[2], kp[3]}; *(LAS f32x4*)(sb + 192 + c0 + 4) = (f32x4){kp[4], kp[5], kp[6], kp[7]};
                    *(LAS f32x4*)(sb + 256 + c0) = (f32x4){wr[0], wr[1], wr[2], wr[3]}; *(LAS f32x4*)(sb + 256 + c0 + 4) = (f32x4){wr[4], wr[5], wr[6], wr[7]};
                    *(LAS f32x4*)(sb + 320 + c0) = (f32x4){v[0], v[1], v[2], v[3]}; *(LAS f32x4*)(sb + 320 + c0 + 4) = (f32x4){v[4], v[5], v[6], v[7]};
                    if ((lt & 7) == 0) { *(LAS f32x2*)(sb + 384) = (f32x2){br, kr}; if (d == 0 && (R == 2 || half == 0)) BONUS[m * 16 + h] = bon; }
                }
                if (ti >= 2) {
                    const int tj = ti - 2; const int js = tj * TT + st, t = d ? T - 1 - js : js;
                    const LAS float* ob = outb + (tj & 1) * RW_OUTF + st * 64 + c0; const f32x4 a = *(const LAS f32x4*)ob, b = *(const LAS f32x4*)(ob + 4);
                    h16x8 o; o[0] = (h16)a[0]; o[1] = (h16)a[1]; o[2] = (h16)a[2]; o[3] = (h16)a[3]; o[4] = (h16)b[0]; o[5] = (h16)b[1]; o[6] = (h16)b[2]; o[7] = (h16)b[3];
                    if (R == 2 || (c0 >> 5) == half) *(h16x8*)(OD + (size_t)t * 1024 + hc) = o;
                }
                __syncthreads();
            }
            {
                const int tj = ntiles - 1; const int js = tj * TT + st, t = d ? T - 1 - js : js;
                const LAS float* ob = outb + (tj & 1) * RW_OUTF + st * 64 + c0; const f32x4 a = *(const LAS f32x4*)ob, b = *(const LAS f32x4*)(ob + 4);
                h16x8 o; o[0] = (h16)a[0]; o[1] = (h16)a[1]; o[2] = (h16)a[2]; o[3] = (h16)a[3]; o[4] = (h16)b[0]; o[5] = (h16)b[1]; o[6] = (h16)b[2]; o[7] = (h16)b[3];
                if (R == 2 || (c0 >> 5) == half) *(h16x8*)(OD + (size_t)t * 1024 + hc) = o;
            }
        }
    }
}

__device__ void phase_rw_post(const Params& p) {
    const h16* P = (const h16*)(p.ws + OFF_P); const h16* OF = (const h16*)p.out; const h16* OB = OF + SZ_ARR / 2;
    const h16* GG = (const h16*)p.out + (size_t)3 * (SZ_ARR / 2); h16* MIX = (h16*)p.out; const float* BONUS = (const float*)(p.ws + OFF_BONUS);
    const int tid = opaque_tid(), hh = (tid & 127) >> 3, c0 = (tid & 7) * 8, hc = hh * 64 + c0;
    float gw[8], gb[8], mp[8], mn[8];
#pragma unroll
    for (int e = 0; e < 8; ++e) { gw[e] = p.gn_w[hc + e]; gb[e] = p.gn_b[hc + e]; mp[e] = p.mu_prev[2048 + hc + e]; mn[e] = p.mu_next[2048 + hc + e]; }
    struct LdR { h16x8 of, ob, gg, vc, vp, vn; float bon; };
    auto ld = [&](int m, LdR& x) {
        const int T = m < NPROMPT ? 4096 : 16384, t = m < NPROMPT ? (m & 4095) : (m - NPROMPT);
        const h16* ofp = m < NPROMPT ? OF + (size_t)m * 1024 : (const h16*)(p.ws + OFF_WUP) + (size_t)(m - NPROMPT) * 1024; const h16* obp = m < NPROMPT ? OB + (size_t)m * 1024 : (const h16*)(p.ws + OFF_WUP) + (size_t)16384 * 1024 + (size_t)(m - NPROMPT) * 1024;
        x.of = ldh8(ofp + hc); x.ob = ldh8(obp + hc); x.gg = ldh8(GG + (size_t)m * 1024 + hc);
        const h16* pv = P + (size_t)m * INC + 2048 + hc; x.vc = ldh8(pv); x.vp = t > 0 ? ldh8(pv - INC) : zeroh8(); x.vn = t < T - 1 ? ldh8(pv + INC) : zeroh8();
        x.bon = BONUS[(size_t)m * 16 + hh]; };
    auto fin = [&](int m, const LdR& x) {
        float o[8]; float sm = 0.f;
#pragma unroll
        for (int e = 0; e < 8; ++e) { o[e] = (float)x.of[e] + (float)x.ob[e]; sm += o[e]; }
        const float mu = red8(sm) * (1.f / 64.f); float vs = 0.f;
#pragma unroll
        for (int e = 0; e < 8; ++e) { o[e] -= mu; vs += o[e] * o[e]; }
        const float rstd = rsqrtf(red8(vs) * (1.f / 64.f) + 64e-5f);
        h16x8 r;
#pragma unroll
        for (int e = 0; e < 8; ++e) { const float z = (float)x.vc[e]; const float v = z + mp[e] * ((float)x.vp[e] - z) + mn[e] * ((float)x.vn[e] - z);
            r[e] = (h16)((o[e] * rstd * gw[e] + gb[e] + x.bon * v) * (float)x.gg[e]); }
        *(h16x8*)(MIX + (size_t)m * 1024 + hc) = r; };
    const int mstep = gridDim.x * 4;
    for (int m = blockIdx.x * 4 + (tid >> 7); m < MT; m += 2 * mstep) {
        LdR xa, xb; const bool hb = m + mstep < MT;
        ld(m, xa); if (hb) ld(m + mstep, xb);
        fin(m, xa); if (hb) fin(m + mstep, xb);
    }
}

constexpr int GD_STRIDE = 356, GD_INF = TT * GD_STRIDE, GD_OUTF = TT * 32;
constexpr int GDC = RWC;
__device__ __forceinline__ void conv_silu8(const h16* pc, bool hp, bool hn, const float* cw, float* out) {
    const h16x8 xc = ldh8(pc), xp = hp ? ldh8(pc - INC) : zeroh8(), xn = hn ? ldh8(pc + INC) : zeroh8();
    const f32x4 w0a = *(const f32x4*)cw, w0b = *(const f32x4*)(cw + 4), w1a = *(const f32x4*)(cw + 3072), w1b = *(const f32x4*)(cw + 3076), w2a = *(const f32x4*)(cw + 6144), w2b = *(const f32x4*)(cw + 6148);
#pragma unroll
    for (int e = 0; e < 8; ++e) { const float a0 = e < 4 ? w0a[e & 3] : w0b[e & 3], a1 = e < 4 ? w1a[e & 3] : w1b[e & 3], a2 = e < 4 ? w2a[e & 3] : w2b[e & 3];
        out[e] = fsilu((float)xp[e] * a0 + (float)xc[e] * a1 + (float)xn[e] * a2); }
}
__device__ __forceinline__ void gd_task(const Params& p, LAS unsigned char* shm, const int tid, const int s, const int d, const int h, const int rq) {
    LAS float* inb = (LAS float*)shm; LAS float* outb = inb + 2 * GD_INF;
    const h16* P = (const h16*)(p.ws + OFF_P);
    h16* OUTS = (h16*)(p.ws + OFF_XH);
    {
        const int T = s < 8 ? 4096 : 16384, base = s < 8 ? s * 4096 : NPROMPT, ntiles = T / TT;
        h16* OD = OUTS + (size_t)d * (SZ_ARR / 2);
        if (__builtin_amdgcn_readfirstlane(tid >> 6) < 4) {
            const int w = tid >> 6, l = tid & 63, j = l & 7, rs = l >> 3; const int row = w * 8 + rs;
            f32x2 sv[8];
#pragma unroll
            for (int e = 0; e < 8; ++e) sv[e] = (f32x2){0.f, 0.f};
            __syncthreads();
            for (int ti = 0; ti < ntiles; ++ti) {
                const LAS float* ib = inb + (ti & 1) * GD_INF; LAS float* ob = outb + (ti & 1) * GD_OUTF;
                LAS float* ow0 = j == 0 ? ob + row : outb + 2 * GD_OUTF + l; const int omask = j == 0 ? -1 : 0;
#pragma unroll 2
                for (int st = 0; st < TT; ++st) {
                    const LAS float* sb = ib + st * GD_STRIDE;
                    f32x2 kk[8], qq[8];
#pragma unroll
                    for (int e = 0; e < 4; ++e) { const f32x4 a = *(const LAS f32x4*)(sb + 20 * j + 4 * e), b = *(const LAS f32x4*)(sb + 160 + 20 * j + 4 * e);
                        kk[2 * e] = (f32x2){a[0], a[1]}; kk[2 * e + 1] = (f32x2){a[2], a[3]}; qq[2 * e] = (f32x2){b[0], b[1]}; qq[2 * e + 1] = (f32x2){b[2], b[3]}; }
                    const float v = sb[320 + row]; const f32x4 sc = *(const LAS f32x4*)(sb + 352); const float wdec = sc[0], cc = sc[1], kq = sc[2], beta = sc[3];
                    f32x2 pa = sv[0] * kk[0], px = sv[0] * qq[0], pa2 = sv[1] * kk[1], px2 = sv[1] * qq[1];
#pragma unroll
                    for (int e = 2; e < 8; e += 2) { pa += sv[e] * kk[e]; px += sv[e] * qq[e]; pa2 += sv[e + 1] * kk[e + 1]; px2 += sv[e + 1] * qq[e + 1]; }
                    pa += pa2; px += px2;
                    const float sa = red8(pa[0] + pa[1]), x = red8(px[0] + px[1]);
                    const float coef = beta * v - cc * sa; const float o = wdec * x + coef * kq;
                    const f32x2 wd2 = (f32x2){wdec, wdec}, cf2 = (f32x2){coef, coef};
#pragma unroll
                    for (int e = 0; e < 8; ++e) sv[e] = sv[e] * wd2 + cf2 * kk[e];
                    ow0[(st * 32) & omask] = o;
                }
                __syncthreads();
            }
        } else {
            const int lt = tid - 256, st = lt >> 3, jj = lt & 7;
            const int qcol = h * 128 + 16 * jj, kcol = 1024 + h * 128 + 16 * jj, vcol = 2048 + h * 128 + rq * 32 + 4 * jj;
            const float alog = -expf(p.a_log[d * 8 + h]), dtb = p.dt_bias[d * 8 + h];
            for (int ti = 0; ti <= ntiles; ++ti) {
                if (ti < ntiles) {
                    const int js = ti * TT + st, t = d ? T - 1 - js : js; const size_t m = (size_t)base + t;
                    const h16* pr = P + m * INC + GDC; const bool hp = t > 0, hn = t < T - 1;
                    const h16 bbv = pr[4096 + h], aav = pr[4104 + d * 8 + h];
                    float q[16], k[16];
                    conv_silu8(pr + qcol, hp, hn, p.gd_conv + qcol, q); conv_silu8(pr + qcol + 8, hp, hn, p.gd_conv + qcol + 8, q + 8);
                    conv_silu8(pr + kcol, hp, hn, p.gd_conv + kcol, k); conv_silu8(pr + kcol + 8, hp, hn, p.gd_conv + kcol + 8, k + 8);
                    float v[4];
                    { const h16* pc = pr + vcol; const h16x4 xc = *(const h16x4*)pc, xp = hp ? *(const h16x4*)(pc - INC) : (h16x4){(h16)0.f, (h16)0.f, (h16)0.f, (h16)0.f}, xn = hn ? *(const h16x4*)(pc + INC) : (h16x4){(h16)0.f, (h16)0.f, (h16)0.f, (h16)0.f};
                      const f32x4 a0 = *(const f32x4*)(p.gd_conv + vcol), a1 = *(const f32x4*)(p.gd_conv + 3072 + vcol), a2 = *(const f32x4*)(p.gd_conv + 6144 + vcol);
#pragma unroll
                      for (int e = 0; e < 4; ++e) v[e] = fsilu((float)xp[e] * a0[e] + (float)xc[e] * a1[e] + (float)xn[e] * a2[e]); }
                    float nq = 0.f, nk = 0.f;
#pragma unroll
                    for (int e = 0; e < 16; ++e) { nq += q[e] * q[e]; nk += k[e] * k[e]; }
                    nq = red8(nq); nk = red8(nk);
                    const float rq_ = rsqrtf(nq + 1e-6f) * 0.08838834764831845f, rk_ = rsqrtf(nk + 1e-6f);
                    float kq = 0.f;
#pragma unroll
                    for (int e = 0; e < 16; ++e) { q[e] *= rq_; k[e] *= rk_; kq += q[e] * k[e]; }
                    kq = red8(kq);
                    LAS float* sb = inb + (ti & 1) * GD_INF + st * GD_STRIDE;
#pragma unroll
                    for (int e = 0; e < 4; ++e) { *(LAS f32x4*)(sb + 20 * jj + 4 * e) = (f32x4){k[4 * e], k[4 * e + 1], k[4 * e + 2], k[4 * e + 3]};
                        *(LAS f32x4*)(sb + 160 + 20 * jj + 4 * e) = (f32x4){q[4 * e], q[4 * e + 1], q[4 * e + 2], q[4 * e + 3]}; }
                    *(LAS f32x4*)(sb + 320 + 4 * jj) = (f32x4){v[0], v[1], v[2], v[3]};
                    if (jj == 0) { const float beta = fsigmoid((float)bbv); const float ain = (float)aav;
                        const float g = alog * softplusf_(ain + dtb); const float wdec = __expf(g);
                        *(LAS f32x4*)(sb + 352) = (f32x4){wdec, wdec * beta, kq, beta}; }
                }
                if (ti >= 2) {
                    const int tj = ti - 2; const int js = tj * TT + st, t = d ? T - 1 - js : js; const size_t m = (size_t)base + t;
                    const f32x4 a = *(const LAS f32x4*)(outb + (tj & 1) * GD_OUTF + st * 32 + 4 * jj);
                    h16x4 o; o[0] = (h16)a[0]; o[1] = (h16)a[1]; o[2] = (h16)a[2]; o[3] = (h16)a[3];
                    *(h16x4*)(OD + m * 1024 + h * 128 + rq * 32 + 4 * jj) = o;
                }
                __syncthreads();
            }
            {
                const int tj = ntiles - 1; const int js = tj * TT + st, t = d ? T - 1 - js : js; const size_t m = (size_t)base + t;
                const f32x4 a = *(const LAS f32x4*)(outb + (tj & 1) * GD_OUTF + st * 32 + 4 * jj);
                h16x4 o; o[0] = (h16)a[0]; o[1] = (h16)a[1]; o[2] = (h16)a[2]; o[3] = (h16)a[3];
                *(h16x4*)(OD + m * 1024 + h * 128 + rq * 32 + 4 * jj) = o;
            }
        }
    }
}

constexpr int GD_KS = 136;
constexpr int GD_VS = 132;
constexpr int GD_QH = 32 * GD_KS * 2, GD_V = 2 * GD_QH, GD_SC = GD_V + 32 * GD_VS * 4, GD_BUF = GD_SC + 512;
constexpr int GD_OUT0 = 2 * GD_BUF, GD_OUTB = 32 * GD_VS * 4, GD_WV0 = GD_OUT0 + 2 * GD_OUTB, GD_WVB = 2048 + 64, GD_CW0 = GD_WV0 + 8 * GD_WVB;
constexpr int LDS_TASK_OFF = 139264;
static_assert(GD_CW0 + 3 * 384 * 4 <= LDS_TASK_OFF, "gdn lds map");
template <int CTRL> __device__ __forceinline__ float dpp_shr0(float x) { return __builtin_bit_cast(float, __builtin_amdgcn_update_dpp(0, __builtin_bit_cast(int, x), CTRL, 0xF, 0xF, true)); }
__device__ __forceinline__ void gd_mfma_task(const Params& p, LAS unsigned char* shm, const int tid, const int s, const int d, const int h) {
    const h16* P = (const h16*)(p.ws + OFF_P);
    h16* OD = (h16*)(p.ws + OFF_XH) + (size_t)d * (SZ_ARR / 2);
    const int T = s < 8 ? 4096 : 16384, base = s < 8 ? s * 4096 : NPROMPT, ntiles = T / 32;
    const int wv = __builtin_amdgcn_readfirstlane(tid >> 6);
    LAS float* CW = (LAS float*)(shm + GD_CW0);
    LAS float* GCW = (LAS float*)(shm + GD_WV0 + wv * GD_WVB); LAS float* HDW = GCW + 16;
    for (int i = tid; i < 1152; i += 512) { const int tap = i / 384, c = i - tap * 384; const int part = c >> 7, cc = c & 127; CW[i] = p.gd_conv[(size_t)tap * 3072 + part * 1024 + h * 128 + cc]; }
    const float alog = -expf(p.a_log[d * 8 + h]), dtb = p.dt_bias[d * 8 + h];
    f32x4 acc[8];
#pragma unroll
    for (int t = 0; t < 8; ++t) acc[t] = (f32x4){0.f, 0.f, 0.f, 0.f};
    struct Raw { h16x8 q[3], k[3], v[3]; h16 b, a; };
    auto issue = [&](int ti, Raw& x) {
        const int tid2 = opaque_tid(), lst = tid2 >> 4, c8 = (tid2 & 15) * 8;
        const int js = ti * 32 + lst, t = d ? T - 1 - js : js; const size_t m = (size_t)base + t;
        const h16* pr = P + m * INC + GDC + h * 128 + c8; const bool hp = t > 0, hn = t < T - 1;
        x.q[1] = ldh8(pr); x.q[0] = hp ? ldh8(pr - INC) : zeroh8(); x.q[2] = hn ? ldh8(pr + INC) : zeroh8();
        x.k[1] = ldh8(pr + 1024); x.k[0] = hp ? ldh8(pr + 1024 - INC) : zeroh8(); x.k[2] = hn ? ldh8(pr + 1024 + INC) : zeroh8();
        x.v[1] = ldh8(pr + 2048); x.v[0] = hp ? ldh8(pr + 2048 - INC) : zeroh8(); x.v[2] = hn ? ldh8(pr + 2048 + INC) : zeroh8();
        const h16* ps = P + m * INC + GDC + 4096; x.b = ps[h]; x.a = ps[8 + d * 8 + h]; };
    auto process = [&](int ti, const Raw& x) {
        const int tid2 = opaque_tid(), lst = tid2 >> 4, sl = tid2 & 15, c8 = sl * 8;
        LAS unsigned char* ib = shm + (ti & 1) * GD_BUF;
        float qv[8], kv[8], vv[8]; float nq = 0.f, nk = 0.f;
#pragma unroll
        for (int hf = 0; hf < 2; ++hf) {
            const f32x4 q0 = *(const LAS f32x4*)(CW + c8 + 4 * hf), q1 = *(const LAS f32x4*)(CW + 384 + c8 + 4 * hf), q2 = *(const LAS f32x4*)(CW + 768 + c8 + 4 * hf);
            const f32x4 k0 = *(const LAS f32x4*)(CW + 128 + c8 + 4 * hf), k1 = *(const LAS f32x4*)(CW + 512 + c8 + 4 * hf), k2 = *(const LAS f32x4*)(CW + 896 + c8 + 4 * hf);
            const f32x4 v0 = *(const LAS f32x4*)(CW + 256 + c8 + 4 * hf), v1 = *(const LAS f32x4*)(CW + 640 + c8 + 4 * hf), v2 = *(const LAS f32x4*)(CW + 1024 + c8 + 4 * hf);
#pragma unroll
            for (int e = 0; e < 4; ++e) { const int c = 4 * hf + e;
                qv[c] = fsilu((float)x.q[0][c] * q0[e] + (float)x.q[1][c] * q1[e] + (float)x.q[2][c] * q2[e]);
                kv[c] = fsilu((float)x.k[0][c] * k0[e] + (float)x.k[1][c] * k1[e] + (float)x.k[2][c] * k2[e]);
                vv[c] = fsilu((float)x.v[0][c] * v0[e] + (float)x.v[1][c] * v1[e] + (float)x.v[2][c] * v2[e]);
                nq += qv[c] * qv[c]; nk += kv[c] * kv[c]; } }
        nq = red16(nq); nk = red16(nk);
        const float rq_ = rsqrtf(nq + 1e-6f) * 0.08838834764831845f, rk_ = rsqrtf(nk + 1e-6f);
        const float beta = fsigmoid((float)x.b);
        h16x8 kh, qh; f32x4 va, vb;
#pragma unroll
        for (int c = 0; c < 8; ++c) { kh[c] = (h16)(kv[c] * rk_); qh[c] = (h16)(qv[c] * rq_); }
        va = (f32x4){vv[0] * beta, vv[1] * beta, vv[2] * beta, vv[3] * beta}; vb = (f32x4){vv[4] * beta, vv[5] * beta, vv[6] * beta, vv[7] * beta};
        *(LAS h16x8*)(ib + (lst * GD_KS + c8) * 2) = kh; *(LAS h16x8*)(ib + GD_QH + (lst * GD_KS + c8) * 2) = qh;
        *(LAS f32x4*)(ib + GD_V + (lst * GD_VS + c8) * 4) = va; *(LAS f32x4*)(ib + GD_V + (lst * GD_VS + c8 + 4) * 4) = vb;
        if (sl == 0) { const float g = alog * softplusf_((float)x.a + dtb); const float wd = __expf(g); *(LAS f32x4*)(ib + GD_SC + lst * 16) = (f32x4){g, wd, wd * beta, 0.f}; } };
    auto flush = [&](int ti) {
        const int tid2 = opaque_tid(), lst = tid2 >> 4, c8 = (tid2 & 15) * 8;
        const int js = ti * 32 + lst, t = d ? T - 1 - js : js; const size_t m = (size_t)base + t;
        const LAS float* ob = (const LAS float*)(shm + GD_OUT0 + (ti & 1) * GD_OUTB) + lst * GD_VS + c8; const f32x4 a = *(const LAS f32x4*)ob, b = *(const LAS f32x4*)(ob + 4);
        h16x8 o; o[0] = (h16)a[0]; o[1] = (h16)a[1]; o[2] = (h16)a[2]; o[3] = (h16)a[3]; o[4] = (h16)b[0]; o[5] = (h16)b[1]; o[6] = (h16)b[2]; o[7] = (h16)b[3];
        *(h16x8*)(OD + m * 1024 + h * 128 + c8) = o; };
    auto chunk = [&](int cc, const LAS unsigned char* ib, LAS float* ob) {
        const int lane2 = opaque_tid() & 63, r = lane2 & 15, q = lane2 >> 4;
        const LAS h16* Kh = (const LAS h16*)ib; const LAS h16* Qh = (const LAS h16*)(ib + GD_QH); const LAS float* Vb = (const LAS float*)(ib + GD_V); const LAS float* SC = (const LAS float*)(ib + GD_SC);
        const int s0 = cc * 16;
        h16x8 kf[4], qf[4];
#pragma unroll
        for (int t = 0; t < 4; ++t) {
            const h16x4 k0 = *(const LAS h16x4*)(Kh + (s0 + r) * GD_KS + 32 * t + 4 * q), k1 = *(const LAS h16x4*)(Kh + (s0 + r) * GD_KS + 32 * t + 16 + 4 * q);
            const h16x4 q0 = *(const LAS h16x4*)(Qh + (s0 + r) * GD_KS + 32 * t + 4 * q), q1 = *(const LAS h16x4*)(Qh + (s0 + r) * GD_KS + 32 * t + 16 + 4 * q);
            kf[t][0] = k0[0]; kf[t][1] = k0[1]; kf[t][2] = k0[2]; kf[t][3] = k0[3]; kf[t][4] = k1[0]; kf[t][5] = k1[1]; kf[t][6] = k1[2]; kf[t][7] = k1[3];
            qf[t][0] = q0[0]; qf[t][1] = q0[1]; qf[t][2] = q0[2]; qf[t][3] = q0[3]; qf[t][4] = q1[0]; qf[t][5] = q1[1]; qf[t][6] = q1[2]; qf[t][7] = q1[3]; }
        f32x4 G = (f32x4){0.f, 0.f, 0.f, 0.f}, H = G;
#pragma unroll
        for (int t = 0; t < 4; ++t) { G = __builtin_amdgcn_mfma_f32_16x16x32_f16(kf[t], kf[t], G, 0, 0, 0); H = __builtin_amdgcn_mfma_f32_16x16x32_f16(kf[t], qf[t], H, 0, 0, 0); }
        const f32x4 scr = *(const LAS f32x4*)(SC + (s0 + r) * 4);
        float gc = scr[0]; gc += dpp_shr0<0x111>(gc); gc += dpp_shr0<0x112>(gc); gc += dpp_shr0<0x114>(gc); gc += dpp_shr0<0x118>(gc);
        const float gce_r = gc - scr[0], wb_r = scr[2];
        GCW[r] = gc;
        HDW[(r >> 2) == q ? r : 32 + lane2] = H[r & 3];
        const f32x4 gca = *(const LAS f32x4*)(GCW + 4 * q), hda = *(const LAS f32x4*)(HDW + 4 * q); const float gc15 = GCW[15];
        f32x4 w_a, wb_a, dm_a, e_a, gce4;
#pragma unroll
        for (int e = 0; e < 4; ++e) { const f32x4 sa = *(const LAS f32x4*)(SC + (s0 + 4 * q + e) * 4); w_a[e] = sa[1]; wb_a[e] = sa[2]; gce4[e] = gca[e] - sa[0]; dm_a[e] = __expf(gce4[e]); e_a[e] = __expf(gc15 - gca[e]); }
        f32x4 Lm, Lt, HRt;
#pragma unroll
        for (int e = 0; e < 4; ++e) { const int aa = 4 * q + e;
            const float gce_a = gce4[e];
            const float fu = __expf(fminf(gce_r - gca[e], 0.f));
            const float fl = __expf(fminf(gce_a - gc, 0.f));
            Lt[e] = aa < r ? wb_r * G[e] * fu : 0.f;
            Lm[e] = r < aa ? wb_a[e] * G[e] * fl : 0.f;
            HRt[e] = aa < r ? H[e] * fu : 0.f; }
        auto pk = [](const f32x4 x) { h16x8 o; o[0] = (h16)x[0]; o[1] = (h16)x[1]; o[2] = (h16)x[2]; o[3] = (h16)x[3]; o[4] = (h16)0.f; o[5] = (h16)0.f; o[6] = (h16)0.f; o[7] = (h16)0.f; return o; };
        auto mm = [&](const f32x4 X, const f32x4 Yb, const f32x4 C) { return __builtin_amdgcn_mfma_f32_16x16x32_f16(pk(X), pk(Yb), C, 0, 0, 0); };
        const f32x4 zero4 = (f32x4){0.f, 0.f, 0.f, 0.f};
        const f32x4 L2t = mm(Lm, Lt, zero4), L2 = mm(Lt, Lm, zero4);
        const f32x4 L4t = mm(L2, L2t, zero4), L4 = mm(L2t, L2, zero4);
        const f32x4 L8t = mm(L4, L4t, zero4);
        f32x4 Y = zero4, Z = zero4;
#pragma unroll
        for (int t = 0; t < 4; ++t) {
            const f32x4 a0 = acc[2 * t], a1 = acc[2 * t + 1]; h16x8 sb;
            sb[0] = (h16)a0[0]; sb[1] = (h16)a0[1]; sb[2] = (h16)a0[2]; sb[3] = (h16)a0[3]; sb[4] = (h16)a1[0]; sb[5] = (h16)a1[1]; sb[6] = (h16)a1[2]; sb[7] = (h16)a1[3];
            Y = __builtin_amdgcn_mfma_f32_16x16x32_f16(kf[t], sb, Y, 0, 0, 0); Z = __builtin_amdgcn_mfma_f32_16x16x32_f16(qf[t], sb, Z, 0, 0, 0); }
        f32x4 rhs;
#pragma unroll
        for (int e = 0; e < 4; ++e) rhs[e] = Vb[(s0 + 4 * q + e) * GD_VS + wv * 16 + r] - wb_a[e] * dm_a[e] * Y[e];
        const f32x4 r1 = mm(L8t, rhs, rhs), r2 = mm(L4t, r1, r1), r3 = mm(L2t, r2, r2);
        const f32x4 cv = mm(-Lt, r3, r3);
        f32x4 xz;
#pragma unroll
        for (int e = 0; e < 4; ++e) xz[e] = dm_a[e] * Z[e];
        const f32x4 xx = mm(HRt, cv, xz);
#pragma unroll
        for (int e = 0; e < 4; ++e) ob[(s0 + 4 * q + e) * GD_VS + wv * 16 + r] = w_a[e] * xx[e] + cv[e] * hda[e];
        const float d16 = __expf(gc15);
#pragma unroll
        for (int t = 0; t < 8; ++t) acc[t] *= d16;
        const h16x8 cb = pk(cv * e_a);
#pragma unroll
        for (int t = 0; t < 8; ++t) { h16x8 ka;
#pragma unroll
            for (int e = 0; e < 4; ++e) { ka[e] = Kh[(s0 + 4 * q + e) * GD_KS + 16 * t + r]; ka[4 + e] = (h16)0.f; }
            acc[t] = __builtin_amdgcn_mfma_f32_16x16x32_f16(ka, cb, acc[t], 0, 0, 0); }
    };
    __syncthreads();
    Raw raw;
    issue(0, raw); process(0, raw);
    __syncthreads();
    for (int ti = 0; ti < ntiles; ++ti) {
        const bool more = ti + 1 < ntiles;
        if (more) issue(ti + 1, raw);
        const LAS unsigned char* ib = shm + (ti & 1) * GD_BUF; LAS float* ob = (LAS float*)(shm + GD_OUT0 + (ti & 1) * GD_OUTB);
        chunk(0, ib, ob); chunk(1, ib, ob);
        if (more) process(ti + 1, raw);
        __syncthreads();
        flush(ti);
    }
}

__device__ void phase_scans(const Params& p, LAS unsigned char* shm, int cidx) {
    LAS int* s_task = (LAS int*)(shm + LDS_TASK_OFF);
    unsigned* ctr = (unsigned*)(p.ws + OFF_CTR) + cidx;
    for (;;) {
        const int tid = opaque_tid();
        if (tid == 0) *s_task = (int)atomicAdd(ctr, 1u);
        __syncthreads();
        const int task = __builtin_amdgcn_readfirstlane(*s_task);
        __syncthreads();
        if (task >= 512) break;
        if (task < 64) gd_task(p, shm, tid, 8, task >> 5, (task >> 2) & 7, task & 3);
        else if (task < 128) { const int u = task - 64; rw_task<1>(p, shm, tid, 8, u >> 5, (u >> 1) & 15, u & 1); }
        else if (task < 256) { const int u = task - 128; gd_mfma_task(p, shm, tid, u >> 4, (u >> 3) & 1, u & 7); }
        else { const int u = task - 256; rw_task<2>(p, shm, tid, u >> 5, (u >> 4) & 1, u & 15, 0); }
        __syncthreads();
    }
}


__device__ void phase_gd_post(const Params& p) {
    const h16* P = (const h16*)(p.ws + OFF_P); const h16* OF = (const h16*)(p.ws + OFF_XH); const h16* OB = OF + SZ_ARR / 2; h16* MIX = (h16*)(p.ws + OFF_XH);
    const int tid = opaque_tid(), hh = (tid & 63) >> 3, c0 = (tid & 7) * 16, hc = hh * 128 + c0;
    float nw[16];
#pragma unroll
    for (int e = 0; e < 16; ++e) nw[e] = p.gd_norm[c0 + e];
    for (int m = blockIdx.x * 8 + (tid >> 6); m < MT; m += gridDim.x * 8) {
        float o[16]; float ss = 0.f;
#pragma unroll
        for (int hlf = 0; hlf < 2; ++hlf) { const h16x8 of = ldh8(OF + (size_t)m * 1024 + hc + 8 * hlf), ob = ldh8(OB + (size_t)m * 1024 + hc + 8 * hlf);
#pragma unroll
            for (int e = 0; e < 8; ++e) { o[8 * hlf + e] = (float)of[e] + (float)ob[e]; ss += o[8 * hlf + e] * o[8 * hlf + e]; } }
        const float rr = rsqrtf(red8(ss) * (1.f / 128.f) + 1e-6f);
#pragma unroll
        for (int hlf = 0; hlf < 2; ++hlf) { const h16x8 z = ldh8(P + (size_t)m * INC + GDC + 3072 + hc + 8 * hlf); h16x8 r;
#pragma unroll
            for (int e = 0; e < 8; ++e) r[e] = (h16)(o[8 * hlf + e] * rr * nw[8 * hlf + e] * fsilu((float)z[e]));
            *(h16x8*)(MIX + (size_t)m * 1024 + hc + 8 * hlf) = r; }
    }
}

__device__ void phase_ln(const h16* __restrict__ in, float* __restrict__ out32, h16* __restrict__ out16, const float* __restrict__ g, const float* __restrict__ b) {
    const int tid = opaque_tid(), lane = tid & 63, wv = tid >> 6;
    const int mstep = gridDim.x * 8; h16x4 nx[8];
    { const int m0 = blockIdx.x * 8 + wv; if (m0 < MT) { const h16* rp = in + (size_t)m0 * DM;
#pragma unroll
        for (int i = 0; i < 8; ++i) nx[i] = *(const h16x4*)(rp + i * 256 + lane * 4); } }
    for (int m = blockIdx.x * 8 + wv; m < MT; m += mstep) {
        f32x4 x[8]; float s = 0.f;
#pragma unroll
        for (int i = 0; i < 8; ++i) { const h16x4 hv = nx[i]; x[i] = (f32x4){(float)hv[0], (float)hv[1], (float)hv[2], (float)hv[3]}; s += x[i][0] + x[i][1] + x[i][2] + x[i][3]; }
        if (m + mstep < MT) { const h16* rp = in + (size_t)(m + mstep) * DM;
#pragma unroll
            for (int i = 0; i < 8; ++i) nx[i] = *(const h16x4*)(rp + i * 256 + lane * 4); }
        const float mu = wave_sum(s) * (1.f / DM); float vs = 0.f;
#pragma unroll
        for (int i = 0; i < 8; ++i) { x[i] -= mu; vs += x[i][0] * x[i][0] + x[i][1] * x[i][1] + x[i][2] * x[i][2] + x[i][3] * x[i][3]; }
        const float rstd = rsqrtf(wave_sum(vs) * (1.f / DM) + 1e-5f);
#pragma unroll
        for (int i = 0; i < 8; ++i) { const int c = i * 256 + lane * 4; const f32x4 gg = *(const f32x4*)(g + c), bb = *(const f32x4*)(b + c); const f32x4 y = x[i] * rstd * gg + bb;
            if (out32) *(f32x4*)(out32 + (size_t)m * DM + c) = y;
            if (out16) { h16x4 hv; hv[0] = (h16)y[0]; hv[1] = (h16)y[1]; hv[2] = (h16)y[2]; hv[3] = (h16)y[3]; *(h16x4*)(out16 + (size_t)m * DM + c) = hv; } }
    }
}

__device__ void phase_convact(const Params& p, int grp) {
    const h16* U = (const h16*)p.out; h16* ACT = (h16*)(p.ws + OFF_ACT);
    const int T = grp < 2 ? 4096 : 16384; constexpr int RB = 16, NC8 = DFF / 8;
    const int nitems = (GROWS / RB) * NC8;
    const int tid = opaque_tid();
    for (int it = blockIdx.x * 512 + tid; it < nitems; it += gridDim.x * 512) {
        const int rb = it / NC8, c = (it - rb * NC8) * 8; const int r0 = rb * RB;
        float wg[3][8], wv[3][8];
#pragma unroll
        for (int i = 0; i < 3; ++i)
#pragma unroll
            for (int e = 0; e < 8; ++e) { wg[i][e] = p.ffn_conv[(size_t)i * DFF2 + c + e]; wv[i][e] = p.ffn_conv[(size_t)i * DFF2 + DFF + c + e]; }
#pragma unroll 1
        for (int hb = 0; hb < RB / 8; ++hb) {
            const int rb0 = r0 + 8 * hb; const bool hp = (rb0 & (T - 1)) != 0, hn = ((rb0 + 7) & (T - 1)) != T - 1;
            h16x8 gr[10], vr[10];
#pragma unroll
            for (int k = 0; k < 10; ++k) { const bool ok = (k == 0) ? hp : ((k == 9) ? hn : true); const size_t rr = (size_t)(rb0 - 1 + k);
                if (ok) { gr[k] = ldh8(U + rr * DFF2 + c); vr[k] = ldh8(U + rr * DFF2 + DFF + c); } else { gr[k] = zeroh8(); vr[k] = zeroh8(); } }
#pragma unroll
            for (int i = 0; i < 8; ++i) { h16x8 o;
#pragma unroll
                for (int e = 0; e < 8; ++e) { const float gte = (float)gr[i][e] * wg[0][e] + (float)gr[i + 1][e] * wg[1][e] + (float)gr[i + 2][e] * wg[2][e];
                    const float val = (float)vr[i][e] * wv[0][e] + (float)vr[i + 1][e] * wv[1][e] + (float)vr[i + 2][e] * wv[2][e]; o[e] = (h16)(fsilu(gte) * val); }
                *(h16x8*)(ACT + (size_t)(rb0 + i) * DFF + c) = o; }
        }
    }
}

#define XB_TMO      128
#define XB_XCNT(j)  (256  + 64 * (j))
#define XB_XSUB(j)  (1280 + 64 * (j))
#define XB_XGEN(j)  (2304 + 64 * (j))
#define XB_TOP      3328
#define XB_TOPGEN   3392
#define XCD_BAR_WORDS 3456
#define XB_SPIN_CAP (1u << 22)
constexpr size_t OFF_BAR = OFF_CTR + 1024;
static_assert(1024 + XCD_BAR_WORDS * 4 <= SZ_CTR, "barrier words");
__device__ __forceinline__ unsigned xb_ld(unsigned* p)              { return __hip_atomic_load(p, __ATOMIC_RELAXED, __HIP_MEMORY_SCOPE_AGENT); }
__device__ __forceinline__ unsigned xb_add(unsigned* p, unsigned v) { return __hip_atomic_fetch_add(p, v, __ATOMIC_RELAXED, __HIP_MEMORY_SCOPE_AGENT); }
__device__ __forceinline__ unsigned xb_xcc_id() { return (unsigned)__builtin_amdgcn_s_getreg((3 << 11) | 20) & 0xFu; }
#define XB_SPIN(cond, bar) do { unsigned _sp = 0; while (cond) { __builtin_amdgcn_s_sleep(1); \
    if ((++_sp & 255u) == 0u) { if (xb_ld(&(bar)[XB_TMO])) break; if (_sp > XB_SPIN_CAP) { atomicAdd(&(bar)[XB_TMO], 1u); break; } } } } while (0)
struct XcdBarrier { unsigned* bar; unsigned x; volatile LAS unsigned* st; };
__device__ __forceinline__ XcdBarrier xcd_barrier_post(unsigned* bar, volatile LAS unsigned* st) {
    XcdBarrier b; b.bar = bar; b.x = xb_xcc_id(); b.st = st;
    if (threadIdx.x == 0) (void)xb_add(&bar[XB_XCNT(b.x)], 1u);
    return b;
}
__device__ __forceinline__ void xcd_barrier_complete(unsigned* bar, unsigned x, unsigned& nloc, unsigned& nx) {
    const unsigned G = gridDim.x * gridDim.y * gridDim.z;
    unsigned sum, cnt, mine, sp = 0u;
    for (;;) {
        sum = 0u; cnt = 0u; mine = 0u;
#pragma unroll
        for (unsigned j = 0; j < 16; ++j) { const unsigned c = xb_ld(&bar[XB_XCNT(j)]); sum += c; cnt += (c > 0u) ? 1u : 0u; mine = (j == x) ? c : mine; }
        if (sum == G) break;
        __builtin_amdgcn_s_sleep(1);
        if ((++sp & 255u) == 0u) { if (xb_ld(&bar[XB_TMO])) break; if (sp > XB_SPIN_CAP) { atomicAdd(&bar[XB_TMO], 1u); break; } }
    }
    nloc = mine > 0u ? mine : 1u; nx = cnt > 0u ? cnt : 1u;
}
__device__ __forceinline__ void xcd_barrier(const XcdBarrier& b) {
    asm volatile("s_waitcnt vmcnt(0)" ::: "memory");
    __syncthreads();
    if (threadIdx.x == 0) {
        unsigned* bar = b.bar;
        __builtin_amdgcn_s_waitcnt(0);
        unsigned nloc = b.st[0], nx = b.st[1];
        if (nloc == 0u) { xcd_barrier_complete(bar, b.x, nloc, nx); b.st[0] = nloc; b.st[1] = nx; }
        const unsigned old = xb_add(&bar[XB_XSUB(b.x)], 1u);
        const unsigned gen = old / nloc;
        if (old + 1u == (gen + 1u) * nloc) {
            __builtin_amdgcn_fence(__ATOMIC_RELEASE, "agent");
            asm volatile("s_waitcnt vmcnt(0)" ::: "memory");
            const unsigned og = xb_add(&bar[XB_TOP], 1u);
            const unsigned tg = og / nx;
            if (og + 1u == (tg + 1u) * nx) xb_add(&bar[XB_TOPGEN], 1u);
            else XB_SPIN(xb_ld(&bar[XB_TOPGEN]) == tg, bar);
            __builtin_amdgcn_fence(__ATOMIC_ACQUIRE, "agent");
            xb_add(&bar[XB_XGEN(b.x)], 1u);
            asm volatile("s_waitcnt vmcnt(0)" ::: "memory");
        } else {
            XB_SPIN(xb_ld(&bar[XB_XGEN(b.x)]) == gen, bar);
            __builtin_amdgcn_fence(__ATOMIC_ACQUIRE, "agent");
            asm volatile("s_waitcnt vmcnt(0)" ::: "memory");
        }
    }
    __syncthreads();
}

constexpr int NPH = 18;
__device__ __forceinline__ Gemm mkgemm(const h16* A, const h16* Bt, int M, int N, int K) { return Gemm{A, Bt, M, N, K, A, K / BK, K}; }
__global__ __launch_bounds__(512, 2) void mk_kernel(Params p, int lo, int hi) {
    extern __shared__ __attribute__((aligned(16))) unsigned char shm_raw[];
    LAS unsigned char* shm = (LAS unsigned char*)shm_raw;
    unsigned char* ws = p.ws;
    volatile LAS unsigned* xst = (volatile LAS unsigned*)(shm + LDS_TASK_OFF + 64);
    if (threadIdx.x == 0) { xst[0] = 0u; xst[1] = 0u; }
    __syncthreads();
    const XcdBarrier xb = xcd_barrier_post((unsigned*)(ws + OFF_BAR), xst);
    for (int ph = lo; ph < hi; ++ph) {
        if (ph == lo + 1) cg::this_grid().sync();
        else if (ph > lo) xcd_barrier(xb);
        const int nrep = (ph == REP_PH) ? REP_N : 1;
        for (int rep = 0; rep < nrep; ++rep) {
        int kind = -1, ngemm = 1; Gemm g{}; EpiH16 eh{}; EpiRes er{};
        if (ph == 0) phase_convert(p, shm, 0);
        else if (ph == 1) { kind = 0; g = mkgemm((const h16*)(ws + OFF_XH), (const h16*)(ws + OFF_WIN), MT, INCP, DM); eh = EpiH16{(h16*)(ws + OFF_P), INC, INC, 30, 0}; }
        else if (ph == 2) phase_lora_prep(p);
        else if (ph == 3) { kind = 0; ngemm = 2; }
        else if (ph == 4) phase_scans(p, shm, 4 + 16 * rep);
        else if (ph == 5) { phase_rw_post(p); phase_gd_post(p); }
        else if (ph == 6) { kind = 1; g = Gemm{(const h16*)p.out, (const h16*)(ws + OFF_WOUT), MT, DM, DM, (const h16*)(ws + OFF_XH), 16, 1024}; er = EpiRes{(h16*)(ws + OFF_P), p.xp, p.xs, NPROMPT, nullptr}; }
        else if (ph == 7) { phase_convert(p, shm, 1); phase_ln((const h16*)(ws + OFF_P), nullptr, (h16*)(ws + OFF_XH), p.ln1g, p.ln1b); }
        else if (ph < 17) { const int grp = (ph - 8) / 3, sub = (ph - 8) % 3;
            if (sub == 0) { kind = 0; g = mkgemm((const h16*)(ws + OFF_XH) + (size_t)grp * GROWS * DM, (const h16*)(ws + OFF_WUP), GROWS, DFF2, DM); eh = EpiH16{(h16*)p.out, DFF2, DFF2, 44, 0}; }
            else if (sub == 1) phase_convact(p, grp);
            else { kind = 1; h16* hb = (h16*)(ws + OFF_P) + (size_t)grp * GROWS * DM; g = mkgemm((const h16*)(ws + OFF_ACT), (const h16*)(ws + OFF_WDN), GROWS, DM, DFF); er = EpiRes{hb, nullptr, nullptr, 1 << 30, (const h16*)(ws + OFF_XH) + (size_t)grp * GROWS * DM}; } }
        else phase_ln((const h16*)(ws + OFF_P), p.out, nullptr, p.ln2g, p.ln2b);
        if (kind >= 0) for (int gi = 0; gi < ngemm; ++gi) {
            if (ph == 3) { const h16* lin = (const h16*)(ws + OFF_XH) + 256 * gi; const h16* lt = (const h16*)(ws + OFF_LORAT) + (size_t)3072 * 256 * gi;
                g = Gemm{lin, lt, MT, gi == 0 ? 3072 : 1024, 256, lin, 4, 512}; eh = EpiH16{(h16*)p.out + (size_t)3 * (SZ_ARR / 2) * gi, 1024, 1024, 4, SZ_ARR / 2}; }
            StaticOrder S; S.init(g.M, g.N, (int)gridDim.x, (int)blockIdx.x);
            if (kind == 0) gemm_phase<EpiH16>(shm, g, S, eh); else gemm_phase<EpiRes>(shm, g, S, er); }
        }
    }
}

extern "C" void kernel_launch(void* const* d_in, const int* in_sizes, int n_in, void* d_out, int out_size, void* d_ws, size_t ws_size, hipStream_t stream) {
    Params p{};
    const float** f = (const float**)&p;
    for (int i = 0; i < 27; ++i) f[i] = (const float*)d_in[i];
    p.out = (float*)d_out; p.ws = (unsigned char*)d_ws;
    static int grid = 0;
    if (!grid) {
        hipFuncSetAttribute((const void*)mk_kernel, hipFuncAttributeMaxDynamicSharedMemorySize, LDS_TOTAL);
        int dev = 0, cus = 0, per = 0; hipGetDevice(&dev); hipDeviceGetAttribute(&cus, hipDeviceAttributeMultiprocessorCount, dev);
        hipOccupancyMaxActiveBlocksPerMultiprocessor(&per, mk_kernel, 512, LDS_TOTAL);
        if (per < 1) per = 1;
        grid = cus;
    }
    (void)hipMemsetAsync((unsigned char*)d_ws + OFF_CTR, 0, SZ_CTR, stream);
#if ONE_LAUNCH
    int lo = 0, hi = NPH; void* args[] = {&p, &lo, &hi};
    hipError_t e = hipLaunchCooperativeKernel((void*)mk_kernel, dim3(grid), dim3(512), args, LDS_TOTAL, stream);
    if (e != hipSuccess) fprintf(stderr, "cooperative launch failed: %s\n", hipGetErrorString(e));
#else
    for (int ph = 0; ph < NPH; ++ph) hipLaunchKernelGGL(mk_kernel, dim3(grid), dim3(512), LDS_TOTAL, stream, p, ph, ph + 1);
#endif
}
```

```cpp
#include <hip/hip_runtime.h>
#include <hip/hip_cooperative_groups.h>
#include <cstdio>
namespace cg = cooperative_groups;

typedef _Float16 h16;
typedef _Float16 h16x8 __attribute__((ext_vector_type(8)));
typedef _Float16 h16x4 __attribute__((ext_vector_type(4)));
typedef float f32x4 __attribute__((ext_vector_type(4)));
typedef float f32x2 __attribute__((ext_vector_type(2)));
#define LAS __attribute__((address_space(3)))

#ifndef REP_PH
#define REP_PH -1
#endif
#ifndef REP_N
#define REP_N 2
#endif
#ifndef ONE_LAUNCH
#define ONE_LAUNCH 1
#endif

constexpr int MT = 49152, DM = 2048, INC = 7512, INCP = 7680, DFF = 5632, DFF2 = 11264, RWC = 3392;
constexpr int NPROMPT = 32768;
constexpr int LK = 384;
constexpr int GROWS = 16384;
constexpr float DN_ALPHA = 1.189207115002721f;

constexpr size_t SZ_WIN = (size_t)INCP * DM * 2, SZ_WOUT = (size_t)DM * DM * 2, SZ_WUP = (size_t)DFF2 * DM * 2, SZ_WDN = (size_t)DM * DFF * 2,
                 SZ_LORAT = (size_t)4096 * LK * 2, SZ_CTR = 16384, SZ_BONUS = (size_t)MT * 16 * 4, SZ_XH = (size_t)MT * DM * 2;
constexpr size_t OFF_WIN = 0, OFF_WOUT = OFF_WIN + SZ_WIN, OFF_WUP = OFF_WOUT + SZ_WOUT, OFF_WDN = OFF_WUP + SZ_WUP, OFF_LORAT = OFF_WDN + SZ_WDN,
                 OFF_CTR = OFF_LORAT + SZ_LORAT, OFF_BONUS = OFF_CTR + SZ_CTR, OFF_XH = OFF_BONUS + SZ_BONUS, OFF_P = OFF_XH + SZ_XH;
constexpr size_t SZ_ARR = (size_t)MT * 1024 * 2;
constexpr size_t OFF_ACT = OFF_P + (size_t)MT * DM * 4;

constexpr int LDS_GEMM = 131072;
constexpr int LDS_TOTAL = 139264 + 256;

struct Params {
    const float *xp, *xs, *w_in, *mu_prev, *mu_next, *w0, *w_up, *a0, *a_up, *g_up, *k_k, *k_a, *r_k, *gn_w, *gn_b, *gd_conv, *a_log, *dt_bias, *gd_norm,
        *w_out, *ln1g, *ln1b, *ffn_up, *ffn_conv, *ffn_dn, *ln2g, *ln2b;
    float* out;
    unsigned char* ws;
};

__device__ __forceinline__ int opaque_tid() { int t = threadIdx.x; asm volatile("" : "+v"(t)); return t; }
template <int CTRL> __device__ __forceinline__ float dpp_mov(float x) {
    return __builtin_bit_cast(float, __builtin_amdgcn_update_dpp(0, __builtin_bit_cast(int, x), CTRL, 0xF, 0xF, true));
}
__device__ __forceinline__ float red8(float x) {
    x += dpp_mov<0xB1>(x);
    x += dpp_mov<0x4E>(x);
    x += dpp_mov<0x141>(x);
    return x;
}
__device__ __forceinline__ float red16(float x) { x = red8(x); x += dpp_mov<0x140>(x); return x; }
__device__ __forceinline__ float wave_sum(float x) {
#pragma unroll
    for (int o = 32; o >= 1; o >>= 1) x += __shfl_xor(x, o, 64);
    return x;
}
__device__ __forceinline__ float sigmoidf_(float x) { return 1.0f / (1.0f + expf(-x)); }
__device__ __forceinline__ float softplusf_(float x) { return fmaxf(x, 0.f) + log1pf(expf(-fabsf(x))); }
__device__ __forceinline__ float siluf_(float x) { return x / (1.0f + expf(-x)); }
__device__ __forceinline__ float fsigmoid(float x) { return __builtin_amdgcn_rcpf(1.0f + __expf(-x)); }
__device__ __forceinline__ float fsilu(float x) { return x * fsigmoid(x); }
__device__ __forceinline__ h16x8 ldh8(const h16* p) { return *(const h16x8*)p; }
__device__ __forceinline__ h16x8 zeroh8() { h16x8 z; for (int i = 0; i < 8; ++i) z[i] = (h16)0.f; return z; }

constexpr int BM = 256, BK = 64, HALF = 128, HTB = HALF * BK * 2, NXCD = 8, WGM = 8;
__host__ __device__ __forceinline__ int lds_byte(int r, int c) { const int st = (r >> 4) * 2 + (c >> 5), rr = r & 15, cc = c & 31, ob = rr * 64 + cc * 2; return st * 1024 + (ob ^ (((ob >> 9) & 1) << 5)); }
__host__ __device__ __forceinline__ void stage_rc(int b, int& R, int& C) { const int st = b / 1024, sb = b % 1024, swz = sb ^ (((sb >> 9) & 1) << 5); R = (st >> 1) * 16 + swz / 64; C = (st & 1) * 32 + (swz % 64) / 2; }
__host__ __device__ __forceinline__ int perm32(int rho) { const int n = rho >> 4, i = rho & 15; return 8 * (i >> 2) + 4 * n + (i & 3); }

struct Unit { int pm, pn; };
struct Gemm { const h16* A; const h16* Bt; int M, N, K; const h16* A2; int ks; int lda; };
struct StaticOrder {
    int nM, nN, nwg, G, c;
    __device__ void init(int M, int N, int G_, int c_) { nM = M / BM; nN = N / BM; nwg = nM * nN; G = G_; c = c_; }
    __device__ bool next(int i, Unit& u) const {
        const long L = (long)i * G + c; if (L >= nwg) return false;
        int wgid = (int)L; { const int q = nwg / NXCD, r = nwg % NXCD, xcd = wgid % NXCD, off = wgid / NXCD; wgid = (xcd < r ? xcd * (q + 1) : r * (q + 1) + (xcd - r) * q) + off; }
        const int nig = WGM * nN, gid = wgid / nig, fm = gid * WGM, gsz = (nM - fm) < WGM ? (nM - fm) : WGM;
        u.pm = fm + ((wgid % nig) % gsz); u.pn = (wgid % nig) / gsz; return true;
    }
};

struct EpiH16 {
    static constexpr bool PERM = true;
    h16* C; int ldc; int ncols; int tiles_per_arr; size_t arr_stride;
    __device__ __forceinline__ void operator()(const f32x4 (&acc)[2][2][4][2], const Unit& u, int wr, int wc, int fr, int fq) const {
        const int arr = u.pn / tiles_per_arr, pnl = u.pn - arr * tiles_per_arr;
        h16* base = C + (size_t)arr * arr_stride;
        const int row0 = u.pm * BM + wr * 64 + fr, col0 = pnl * BM + wc * 32 + 8 * fq;
#pragma unroll
        for (int ai = 0; ai < 2; ++ai)
#pragma unroll
            for (int m = 0; m < 4; ++m) { h16* rowp = base + (size_t)(row0 + ai * HALF + m * 16) * ldc + col0;
#pragma unroll
                for (int bj = 0; bj < 2; ++bj) { const f32x4 v0 = acc[ai][bj][m][0], v1 = acc[ai][bj][m][1];
                    h16x8 w; w[0] = (h16)v0[0]; w[1] = (h16)v0[1]; w[2] = (h16)v0[2]; w[3] = (h16)v0[3]; w[4] = (h16)v1[0]; w[5] = (h16)v1[1]; w[6] = (h16)v1[2]; w[7] = (h16)v1[3];
                    if (col0 + bj * HALF < ncols) *(h16x8*)(rowp + bj * HALF) = w; } }
    }
};
struct EpiRes {
    static constexpr bool PERM = false;
    h16* out; const float* res0; const float* res1; int split_row; const h16* resh;
    __device__ __forceinline__ void operator()(const f32x4 (&acc)[2][2][4][2], const Unit& u, int wr, int wc, int fr, int fq) const {
        const int row0 = u.pm * BM + wr * 64 + fr, col0 = u.pn * BM + wc * 32 + 4 * fq;
#pragma unroll
        for (int ai = 0; ai < 2; ++ai) {
            f32x4 r[4][2][2];
#pragma unroll
            for (int m = 0; m < 4; ++m) { const int row = row0 + ai * HALF + m * 16;
                const float* rp = (row < split_row ? res0 + (size_t)row * DM : res1 + (size_t)(row - split_row) * DM) + col0;
#pragma unroll
                for (int bj = 0; bj < 2; ++bj)
#pragma unroll
                    for (int n = 0; n < 2; ++n) {
                        if (resh) { const h16x4 hv = *(const h16x4*)(resh + (size_t)row * DM + col0 + bj * HALF + n * 16); r[m][bj][n] = (f32x4){(float)hv[0], (float)hv[1], (float)hv[2], (float)hv[3]}; }
                        else r[m][bj][n] = *(const f32x4*)(rp + bj * HALF + n * 16); } }
#pragma unroll
            for (int m = 0; m < 4; ++m) { const int row = row0 + ai * HALF + m * 16; h16* op = out + (size_t)row * DM + col0;
#pragma unroll
                for (int bj = 0; bj < 2; ++bj)
#pragma unroll
                    for (int n = 0; n < 2; ++n) { const f32x4 y = r[m][bj][n] * DN_ALPHA + acc[ai][bj][m][n]; h16x4 hy; hy[0] = (h16)y[0]; hy[1] = (h16)y[1]; hy[2] = (h16)y[2]; hy[3] = (h16)y[3];
                        *(h16x4*)(op + bj * HALF + n * 16) = hy; } }
        }
    }
};

template <class Epi>
__device__ __forceinline__ void gemm_phase(LAS unsigned char* lds, const Gemm g, const StaticOrder& S, const Epi& E) {
    const int tid = opaque_tid(), wid = __builtin_amdgcn_readfirstlane(tid >> 6), lane = tid & 63, wr = wid >> 2, wc = wid & 3, fr = lane & 15, fq = lane >> 4;
    const int K = g.K, nt = K / BK;
    unsigned voffA[2], voffB[2];
#pragma unroll
    for (int i = 0; i < 2; ++i) { int R, C; stage_rc(tid * 16 + i * 8192, R, C); const int Rb = Epi::PERM ? ((R & ~31) + perm32(R & 31)) : R;
        voffA[i] = (unsigned)(R * g.lda + C) * 2u; voffB[i] = (unsigned)(Rb * K + C) * 2u; }
    const size_t kstep = (size_t)(BK * 2);
    const size_t hstep = (size_t)HALF * K * 2;
    const size_t tstep = 2 * hstep;
    const size_t hstepA = (size_t)HALF * g.lda * 2, tstepA = 2 * hstepA; const int ks = g.ks;
#define APTR(b1, b2, t) ((t) < ks ? (b1) + (size_t)(t) * kstep : (b2) + (size_t)((t) - ks) * kstep)
    const unsigned ldsw = (unsigned)wid * 1024u;
    const int aoff = lds_byte(wr * 64 + fr, fq * 8), boff = lds_byte(wc * 32 + fr, fq * 8);
#define PG8_SA(b, h) (((b) * 2 + (h)) * HTB)
#define PG8_SB(b, h) ((4 + (b) * 2 + (h)) * HTB)
#define PG8_STAGE(bufoff, gbase, voff) do { _Pragma("unroll") for (int _i = 0; _i < 2; ++_i) \
        __builtin_amdgcn_global_load_lds((const unsigned*)((const char*)(gbase) + (voff)[_i]), (LAS unsigned*)(lds + (bufoff) + ldsw + _i * 8192), 16, 0, 0); } while (0)
#define PG8_LDA(dst, b, h) do { _Pragma("unroll") for (int m = 0; m < 4; ++m) _Pragma("unroll") for (int k = 0; k < 2; ++k) dst[m][k] = *(const LAS h16x8*)(lds + PG8_SA(b, h) + aoff + m * 2048 + k * 1024); } while (0)
#define PG8_LDB(dst, b, h) do { _Pragma("unroll") for (int n = 0; n < 2; ++n) _Pragma("unroll") for (int k = 0; k < 2; ++k) dst[n][k] = *(const LAS h16x8*)(lds + PG8_SB(b, h) + boff + n * 2048 + k * 1024); } while (0)
#define PG8_MMA(ai, bj, At, Bt) do { __builtin_amdgcn_s_setprio(1); _Pragma("unroll") for (int m = 0; m < 4; ++m) _Pragma("unroll") for (int n = 0; n < 2; ++n) _Pragma("unroll") for (int k = 0; k < 2; ++k) \
        acc[ai][bj][m][n] = __builtin_amdgcn_mfma_f32_16x16x32_f16(Bt[n][k], At[m][k], acc[ai][bj][m][n], 0, 0, 0); __builtin_amdgcn_s_setprio(0); } while (0)
#define PG8_WAIT_V(n) asm volatile("s_waitcnt vmcnt(" #n ")" ::: "memory")
#define PG8_WAIT_L(n) asm volatile("s_waitcnt lgkmcnt(" #n ")" ::: "memory")
#define PG8_BAR __builtin_amdgcn_s_barrier()
#define PG8_SCHED __builtin_amdgcn_sched_barrier(0)
    Unit cur, nxt; int ui = 0;
    if (!S.next(0, cur)) return;
    f32x4 acc[2][2][4][2];
#pragma unroll
    for (int a = 0; a < 2; ++a)
#pragma unroll
        for (int b = 0; b < 2; ++b)
#pragma unroll
            for (int m = 0; m < 4; ++m)
#pragma unroll
                for (int n = 0; n < 2; ++n) acc[a][b][m][n] = (f32x4){0.f, 0.f, 0.f, 0.f};
    h16x8 At[4][2], B0[2][2], B1[2][2];
    const char* cA = (const char*)g.A + (size_t)cur.pm * tstepA; const char* cA2 = (const char*)g.A2 + (size_t)cur.pm * tstepA; const char* cB = (const char*)g.Bt + (size_t)cur.pn * tstep;
    PG8_STAGE(PG8_SB(0, 0), cB, voffB); PG8_STAGE(PG8_SA(0, 0), cA, voffA); PG8_STAGE(PG8_SB(0, 1), cB + hstep, voffB); PG8_STAGE(PG8_SA(0, 1), cA + hstepA, voffA);
    if (wr == 1) PG8_BAR;
    PG8_WAIT_V(4); PG8_BAR;
    PG8_STAGE(PG8_SB(1, 0), cB + kstep, voffB); PG8_STAGE(PG8_SA(1, 0), cA + kstep, voffA); PG8_STAGE(PG8_SB(1, 1), cB + hstep + kstep, voffB);
    PG8_WAIT_V(6); PG8_BAR;
    for (;;) {
        const bool has_next = S.next(ui + 1, nxt);
        const char* nA = has_next ? (const char*)g.A + (size_t)nxt.pm * tstepA : cA; const char* nA2 = has_next ? (const char*)g.A2 + (size_t)nxt.pm * tstepA : cA2; const char* nB = has_next ? (const char*)g.Bt + (size_t)nxt.pn * tstep : cB;
        for (int t = 0; t < nt; t += 2) {
            const bool last = (t == nt - 2);
            const char* a1 = APTR(cA, cA2, t + 1);
            const char* a2 = last ? nA : APTR(cA, cA2, t + 2); const char* b2 = last ? nB : cB + (size_t)(t + 2) * kstep;
            const char* a3 = a2 + kstep; const char* b3 = b2 + kstep;
            PG8_LDB(B0, 0, 0); PG8_SCHED; PG8_LDA(At, 0, 0); PG8_STAGE(PG8_SA(1, 1), a1 + hstepA, voffA);
            PG8_WAIT_L(8); PG8_BAR; PG8_WAIT_L(0); PG8_MMA(0, 0, At, B0); PG8_BAR; PG8_SCHED;
            PG8_LDB(B1, 0, 1); PG8_STAGE(PG8_SB(0, 0), b2, voffB);
            PG8_BAR; PG8_WAIT_L(0); PG8_MMA(0, 1, At, B1); PG8_BAR;
            PG8_LDA(At, 0, 1); PG8_STAGE(PG8_SA(0, 0), a2, voffA);
            PG8_BAR; PG8_WAIT_L(0); PG8_MMA(1, 0, At, B0); PG8_BAR; PG8_SCHED;
            PG8_STAGE(PG8_SB(0, 1), b2 + hstep, voffB);
            PG8_WAIT_V(6); PG8_BAR; PG8_MMA(1, 1, At, B1); PG8_BAR;
            PG8_LDB(B0, 1, 0); PG8_SCHED; PG8_LDA(At, 1, 0); PG8_STAGE(PG8_SA(0, 1), a2 + hstepA, voffA);
            PG8_WAIT_L(8); PG8_BAR; PG8_WAIT_L(0); PG8_MMA(0, 0, At, B0); PG8_BAR; PG8_SCHED;
            PG8_LDB(B1, 1, 1); PG8_STAGE(PG8_SB(1, 0), b3, voffB);
            PG8_BAR; PG8_WAIT_L(0); PG8_MMA(0, 1, At, B1); PG8_BAR;
            PG8_LDA(At, 1, 1); PG8_STAGE(PG8_SA(1, 0), a3, voffA);
            PG8_BAR; PG8_WAIT_L(0); PG8_MMA(1, 0, At, B0); PG8_BAR; PG8_SCHED;
            PG8_STAGE(PG8_SB(1, 1), b3 + hstep, voffB);
            PG8_WAIT_V(6); PG8_BAR; PG8_MMA(1, 1, At, B1); PG8_BAR;
        }
        E(acc, cur, wr, wc, fr, fq);
        if (!has_next) break;
#pragma unroll
        for (int a = 0; a < 2; ++a)
#pragma unroll
            for (int b = 0; b < 2; ++b)
#pragma unroll
                for (int m = 0; m < 4; ++m)
#pragma unroll
                    for (int n = 0; n < 2; ++n) acc[a][b][m][n] = (f32x4){0.f, 0.f, 0.f, 0.f};
        cur = nxt; cA = nA; cA2 = nA2; cB = nB; ++ui;
    }
    PG8_WAIT_V(0);
    if (wr == 0) PG8_BAR;
    PG8_BAR;
#undef APTR
#undef PG8_SA
#undef PG8_SB
#undef PG8_STAGE
#undef PG8_LDA
#undef PG8_LDB
#undef PG8_MMA
#undef PG8_WAIT_V
#undef PG8_WAIT_L
#undef PG8_BAR
#undef PG8_SCHED
}

__device__ void transpose_tile(const float* __restrict__ src, int N, h16* __restrict__ dst, int K, int k0, int n0, LAS float* lds) {
    const int tid = opaque_tid();
#pragma unroll
    for (int i = 0; i < 8; ++i) { const int k = (tid >> 6) + 8 * i, n = tid & 63; lds[k * 65 + n] = (n0 + n < N) ? src[(size_t)(k0 + k) * N + n0 + n] : 0.f; }
    __syncthreads();
    { const int n = tid >> 3, kk0 = (tid & 7) * 8; h16x8 v;
#pragma unroll
      for (int e = 0; e < 8; ++e) v[e] = (h16)lds[(kk0 + e) * 65 + n];
      *(h16x8*)(dst + (size_t)(n0 + n) * K + k0 + kk0) = v; }
    __syncthreads();
}
__device__ void phase_convert(const Params& p, LAS unsigned char* shm, const int part) {
    const int tid = opaque_tid(), nb = gridDim.x, b = blockIdx.x;
    unsigned char* ws = p.ws;
    if (part == 0 && b == 0 && tid < 64) ((unsigned*)(ws + OFF_CTR))[tid] = 0u;
    if (part == 0) { h16* XH = (h16*)(ws + OFF_XH); const size_t nvec = (size_t)MT * DM / 8, stride = (size_t)nb * 512;
      for (size_t i0 = (size_t)b * 512 + tid; i0 < nvec; i0 += 4 * stride) {
          f32x4 a[4], bq[4];
#pragma unroll
          for (int u = 0; u < 4; ++u) { const size_t i = i0 + u * stride; const size_t m = i >> 8; const int c = (int)(i & 255) * 8;
              const float* sp = (m < NPROMPT ? p.xp + m * DM : p.xs + (m - NPROMPT) * DM) + c; if (i < nvec) { a[u] = *(const f32x4*)sp; bq[u] = *(const f32x4*)(sp + 4); } }
#pragma unroll
          for (int u = 0; u < 4; ++u) { const size_t i = i0 + u * stride; const size_t m = i >> 8; const int c = (int)(i & 255) * 8;
              h16x8 v; v[0] = (h16)a[u][0]; v[1] = (h16)a[u][1]; v[2] = (h16)a[u][2]; v[3] = (h16)a[u][3]; v[4] = (h16)bq[u][0]; v[5] = (h16)bq[u][1]; v[6] = (h16)bq[u][2]; v[7] = (h16)bq[u][3];
              if (i < nvec) *(h16x8*)(XH + m * DM + c) = v; } } }
    { LAS float* lds = (LAS float*)shm;
      const int t_in = 32 * 118, t_out = 32 * 32, t_up = 32 * 176, t_dn = 88 * 32, tot = t_in + t_out + t_up + t_dn;
      const int tlo = part == 0 ? 0 : t_in + t_out, thi = part == 0 ? t_in + t_out : tot;
      struct TD { const float* src; h16* dst; int N, K, k0, n0; };
      auto desc = [&](int t) { TD d;
          if (t < t_in) { d.src = p.w_in; d.N = INC; d.dst = (h16*)(ws + OFF_WIN); d.K = DM; d.k0 = (t % 32) * 64; d.n0 = (t / 32) * 64; }
          else if (t < t_in + t_out) { const int u = t - t_in; d.src = p.w_out; d.N = DM; d.dst = (h16*)(ws + OFF_WOUT); d.K = DM; d.k0 = (u % 32) * 64; d.n0 = (u / 32) * 64; }
          else if (t < t_in + t_out + t_up) { const int u = t - t_in - t_out; d.src = p.ffn_up; d.N = DFF2; d.dst = (h16*)(ws + OFF_WUP); d.K = DM; d.k0 = (u % 32) * 64; d.n0 = (u / 32) * 64; }
          else { const int u = t - t_in - t_out - t_up; d.src = p.ffn_dn; d.N = DM; d.dst = (h16*)(ws + OFF_WDN); d.K = DFF; d.k0 = (u % 88) * 64; d.n0 = (u / 88) * 64; }
          return d; };
      auto ldtile = [&](const TD& d, float (&r)[8]) {
#pragma unroll
          for (int i = 0; i < 8; ++i) { const int k = (tid >> 6) + 8 * i, n = tid & 63; r[i] = (d.n0 + n < d.N) ? d.src[(size_t)(d.k0 + k) * d.N + d.n0 + n] : 0.f; } };
      int t = tlo + b;
      if (t < thi) {
          TD dc = desc(t); float cur[8]; ldtile(dc, cur);
          for (;;) {
              const int tn = t + nb; const bool more = tn < thi; TD dn = dc; float nxt[8];
#pragma unroll
              for (int i = 0; i < 8; ++i) nxt[i] = 0.f;
              if (more) { dn = desc(tn); ldtile(dn, nxt); }
#pragma unroll
              for (int i = 0; i < 8; ++i) lds[((tid >> 6) + 8 * i) * 65 + (tid & 63)] = cur[i];
              __syncthreads();
              { const int n = tid >> 3, kk0 = (tid & 7) * 8; h16x8 v;
#pragma unroll
                for (int e = 0; e < 8; ++e) v[e] = (h16)lds[(kk0 + e) * 65 + n];
                *(h16x8*)(dc.dst + (size_t)(dc.n0 + n) * dc.K + dc.k0 + kk0) = v; }
              __syncthreads();
              if (!more) break;
              dc = dn; t = tn;
#pragma unroll
              for (int i = 0; i < 8; ++i) cur[i] = nxt[i];
          }
      } }
    if (part == 0) { h16* LT = (h16*)(ws + OFF_LORAT);
      for (int i = b * 512 + tid; i < 4096 * 256; i += nb * 512) { const int n = i >> 8, k = i & 255; float v = 0.f;
          if (n < 3072) { const int blk = n >> 10, nn = n & 1023;
              if (blk == 0) { if (k < 64) v = p.w_up[(size_t)k * 1024 + nn]; }
              else if (blk == 1) { if (k >= 64 && k < 128) v = p.w_up[(size_t)k * 1024 + nn]; }
              else { if (k >= 128 && k < 192) v = p.a_up[(size_t)(k - 128) * 1024 + nn]; } }
          else { if (k < 128) v = p.g_up[(size_t)k * 1024 + (n - 3072)]; }
          LT[i] = (h16)v; } }
}

__device__ void phase_lora_prep(const Params& p) {
    const h16* P = (const h16*)(p.ws + OFF_P); h16* LIN = (h16*)(p.ws + OFF_XH);
    const int nvec = MT * 64;
    const int tid = opaque_tid();
    for (int i = blockIdx.x * 512 + tid; i < nvec; i += gridDim.x * 512) {
        const int m = i >> 6, c = (i & 63) * 8;
        h16x8 o = zeroh8();
        const bool act = c < 192 || (c >= 256 && c < 384);
        if (act) {
            const int T = m < NPROMPT ? 4096 : 16384, t = m < NPROMPT ? (m & 4095) : (m - NPROMPT);
            const int col = c < 192 ? 3072 + c : 3008 + c; const h16* pc = P + (size_t)m * INC + col;
            const h16x8 xc = ldh8(pc), xpv = t > 0 ? ldh8(pc - INC) : zeroh8(), xn = t < T - 1 ? ldh8(pc + INC) : zeroh8();
#pragma unroll
            for (int e = 0; e < 8; ++e) { const float mp = p.mu_prev[col + e], mn = p.mu_next[col + e]; const float x = (float)xc[e];
                const float sv = x + mp * ((float)xpv[e] - x) + mn * ((float)xn[e] - x);
                float r; if (c < 128) r = 2.0f * fsigmoid(2.0f * sv) - 1.0f; else if (c < 192) r = sv; else r = fsigmoid(sv);
                o[e] = (h16)r; }
        }
        *(h16x8*)(LIN + (size_t)m * 512 + c) = o;
    }
}

constexpr int TT = 32;
constexpr int RW_STRIDE = 388, RW_INF = TT * RW_STRIDE, RW_OUTF = TT * 64;
template <int R>
__device__ __forceinline__ void rw_task(const Params& p, LAS unsigned char* shm, const int tid, const int s, const int d, const int h, const int half) {
    LAS float* inb = (LAS float*)shm; LAS float* outb = inb + 2 * RW_INF;
    const h16* P = (const h16*)(p.ws + OFF_P);
    h16* LOR = (h16*)p.out;
    float* BONUS = (float*)(p.ws + OFF_BONUS);
    {
        const int T = s < 8 ? 4096 : 16384, base = s < 8 ? s * 4096 : NPROMPT, ntiles = T / TT;
        const h16* LW = LOR + (size_t)d * (SZ_ARR / 2); const h16* LA = LOR + (size_t)2 * (SZ_ARR / 2);
        h16* OD = R == 2 ? LOR + (size_t)d * (SZ_ARR / 2) + (size_t)base * 1024 : (h16*)(p.ws + OFF_WUP) + (size_t)d * ((size_t)16384 * 1024);
        if (__builtin_amdgcn_readfirstlane(tid >> 6) < 4) {
            const int w = tid >> 6, l = tid & 63, j = l & 7, rs = l >> 3; const int row0 = R == 2 ? w * 16 + rs : half * 32 + w * 8 + rs, row1 = row0 + 8;
            f32x2 s0[4], s1[4];
#pragma unroll
            for (int e = 0; e < 4; ++e) { s0[e] = (f32x2){0.f, 0.f}; s1[e] = (f32x2){0.f, 0.f}; }
            __syncthreads();
            for (int ti = 0; ti < ntiles; ++ti) {
                const LAS float* ib = inb + (ti & 1) * RW_INF; LAS float* ob = outb + (ti & 1) * RW_OUTF;
                LAS float* ow0 = j == 0 ? ob + row0 : outb + 2 * RW_OUTF + l; LAS float* ow1 = j == 0 ? ob + row1 : outb + 2 * RW_OUTF + 64 + l; const int omask = j == 0 ? -1 : 0;
#pragma unroll 2
                for (int st = 0; st < TT; ++st) {
                    const LAS float* sb = ib + st * RW_STRIDE;
                    f32x2 ww[4], kk[4], bb[4], kc[4], wr[4];
                    { const f32x4 a = *(const LAS f32x4*)(sb + 8 * j), b = *(const LAS f32x4*)(sb + 8 * j + 4); ww[0] = (f32x2){a[0], a[1]}; ww[1] = (f32x2){a[2], a[3]}; ww[2] = (f32x2){b[0], b[1]}; ww[3] = (f32x2){b[2], b[3]}; }
                    { const f32x4 a = *(const LAS f32x4*)(sb + 64 + 8 * j), b = *(const LAS f32x4*)(sb + 64 + 8 * j + 4); kk[0] = (f32x2){a[0], a[1]}; kk[1] = (f32x2){a[2], a[3]}; kk[2] = (f32x2){b[0], b[1]}; kk[3] = (f32x2){b[2], b[3]}; }
                    { const f32x4 a = *(const LAS f32x4*)(sb + 128 + 8 * j), b = *(const LAS f32x4*)(sb + 128 + 8 * j + 4); bb[0] = (f32x2){a[0], a[1]}; bb[1] = (f32x2){a[2], a[3]}; bb[2] = (f32x2){b[0], b[1]}; bb[3] = (f32x2){b[2], b[3]}; }
                    { const f32x4 a = *(const LAS f32x4*)(sb + 192 + 8 * j), b = *(const LAS f32x4*)(sb + 192 + 8 * j + 4); kc[0] = (f32x2){a[0], a[1]}; kc[1] = (f32x2){a[2], a[3]}; kc[2] = (f32x2){b[0], b[1]}; kc[3] = (f32x2){b[2], b[3]}; }
                    { const f32x4 a = *(const LAS f32x4*)(sb + 256 + 8 * j), b = *(const LAS f32x4*)(sb + 256 + 8 * j + 4); wr[0] = (f32x2){a[0], a[1]}; wr[1] = (f32x2){a[2], a[3]}; wr[2] = (f32x2){b[0], b[1]}; wr[3] = (f32x2){b[2], b[3]}; }
                    const float v0 = sb[320 + row0], v1 = R == 2 ? sb[320 + row1] : 0.f; const f32x2 sc = *(const LAS f32x2*)(sb + 384); const float br = sc[0], kr = sc[1];
                    if constexpr (R == 2) {
                    f32x2 pa0 = s0[0] * kk[0], px0 = s0[0] * wr[0], pa1 = s1[0] * kk[0], px1 = s1[0] * wr[0];
#pragma unroll
                    for (int e = 1; e < 4; ++e) { pa0 += s0[e] * kk[e]; px0 += s0[e] * wr[e]; pa1 += s1[e] * kk[e]; px1 += s1[e] * wr[e]; }
                    const float sa0 = red8(pa0[0] + pa0[1]), x0 = red8(px0[0] + px0[1]), sa1 = red8(pa1[0] + pa1[1]), x1 = red8(px1[0] + px1[1]);
                    const float o0 = x0 - sa0 * br + v0 * kr, o1 = x1 - sa1 * br + v1 * kr;
                    const f32x2 nsa0 = (f32x2){-sa0, -sa0}, nsa1 = (f32x2){-sa1, -sa1}, vv0 = (f32x2){v0, v0}, vv1 = (f32x2){v1, v1};
#pragma unroll
                    for (int e = 0; e < 4; ++e) { s0[e] = s0[e] * ww[e] + nsa0 * bb[e] + vv0 * kc[e]; s1[e] = s1[e] * ww[e] + nsa1 * bb[e] + vv1 * kc[e]; }
                    ow0[(st * 64) & omask] = o0; ow1[(st * 64) & omask] = o1;
                    } else {
                    f32x2 pa0 = s0[0] * kk[0], px0 = s0[0] * wr[0], pa1 = s0[1] * kk[1], px1 = s0[1] * wr[1];
                    pa0 += s0[2] * kk[2]; px0 += s0[2] * wr[2]; pa1 += s0[3] * kk[3]; px1 += s0[3] * wr[3];
                    pa0 += pa1; px0 += px1;
                    const float sa0 = red8(pa0[0] + pa0[1]), x0 = red8(px0[0] + px0[1]);
                    const float o0 = x0 - sa0 * br + v0 * kr;
                    const f32x2 nsa0 = (f32x2){-sa0, -sa0}, vv0 = (f32x2){v0, v0};
#pragma unroll
                    for (int e = 0; e < 4; ++e) s0[e] = s0[e] * ww[e] + nsa0 * bb[e] + vv0 * kc[e];
                    ow0[(st * 64) & omask] = o0; (void)ow1;
                    (void)v1; (void)row1;
                    }
                }
                __syncthreads();
            }
        } else {
            const int lt = tid - 256, st = lt >> 3, c0 = (lt & 7) * 8, hc = h * 64 + c0;
            float mpr[8], mnr[8], mpk[8], mnk[8], mpv[8], mnv[8], w0v[8], a0v[8], kkv[8], kav[8], rkv[8];
#pragma unroll
            for (int e = 0; e < 8; ++e) { mpr[e] = p.mu_prev[hc + e]; mnr[e] = p.mu_next[hc + e]; mpk[e] = p.mu_prev[1024 + hc + e]; mnk[e] = p.mu_next[1024 + hc + e];
                mpv[e] = p.mu_prev[2048 + hc + e]; mnv[e] = p.mu_next[2048 + hc + e]; w0v[e] = p.w0[d * 1024 + hc + e]; a0v[e] = p.a0[hc + e]; kkv[e] = p.k_k[hc + e]; kav[e] = p.k_a[hc + e]; rkv[e] = p.r_k[hc + e]; }
            for (int ti = 0; ti <= ntiles; ++ti) {
                if (ti < ntiles) {
                    const int js = ti * TT + st, t = d ? T - 1 - js : js; const size_t m = (size_t)base + t;
                    const h16* pr = P + m * INC + hc; const bool hp = t > 0, hn = t < T - 1;
                    const h16x8 rc = ldh8(pr), rp = hp ? ldh8(pr - INC) : zeroh8(), rn = hn ? ldh8(pr + INC) : zeroh8();
                    const h16x8 kc = ldh8(pr + 1024), kp_ = hp ? ldh8(pr + 1024 - INC) : zeroh8(), kn = hn ? ldh8(pr + 1024 + INC) : zeroh8();
                    const h16x8 vc = ldh8(pr + 2048), vp = hp ? ldh8(pr + 2048 - INC) : zeroh8(), vn = hn ? ldh8(pr + 2048 + INC) : zeroh8();
                    const h16x8 wl = ldh8(LW + m * 1024 + hc), al = ldh8(LA + m * 1024 + hc);
                    float r[8], k[8], v[8], wd[8], a[8], kkr[8]; float nrm = 0.f;
#pragma unroll
                    for (int e = 0; e < 8; ++e) { const float x = (float)rc[e]; r[e] = x + mpr[e] * ((float)rp[e] - x) + mnr[e] * ((float)rn[e] - x);
                        const float y = (float)kc[e]; k[e] = y + mpk[e] * ((float)kp_[e] - y) + mnk[e] * ((float)kn[e] - y);
                        const float z = (float)vc[e]; v[e] = z + mpv[e] * ((float)vp[e] - z) + mnv[e] * ((float)vn[e] - z);
                        const float wpre = w0v[e] + (float)wl[e]; wd[e] = __expf(-0.6065306597126334f * fsigmoid(wpre));
                        a[e] = fsigmoid(a0v[e] + (float)al[e]); kkr[e] = k[e] * kkv[e]; nrm += kkr[e] * kkr[e]; }
                    nrm = red8(nrm); const float rinv = rsqrtf(nrm + 1e-6f);
                    float br = 0.f, kr = 0.f, bon = 0.f; float kk[8], bb[8], kp[8], wr[8];
#pragma unroll
                    for (int e = 0; e < 8; ++e) { kk[e] = kkr[e] * rinv; bb[e] = kk[e] * a[e]; kp[e] = k[e] * (1.f + (a[e] - 1.f) * kav[e]); wr[e] = wd[e] * r[e];
                        br += bb[e] * r[e]; kr += kp[e] * r[e]; bon += r[e] * kp[e] * rkv[e]; }
                    br = red8(br); kr = red8(kr); bon = red8(bon);
                    LAS float* sb = inb + (ti & 1) * RW_INF + st * RW_STRIDE;
                    *(LAS f32x4*)(sb + c0) = (f32x4){wd[0], wd[1], wd[2], wd[3]}; *(LAS f32x4*)(sb + c0 + 4) = (f32x4){wd[4], wd[5], wd[6], wd[7]};
                    *(LAS f32x4*)(sb + 64 + c0) = (f32x4){kk[0], kk[1], kk[2], kk[3]}; *(LAS f32x4*)(sb + 64 + c0 + 4) = (f32x4){kk[4], kk[5], kk[6], kk[7]};
                    *(LAS f32x4*)(sb + 128 + c0) = (f32x4){bb[0], bb[1], bb[2], bb[3]}; *(LAS f32x4*)(sb + 128 + c0 + 4) = (f32x4){bb[4], bb[5], bb[6], bb[7]};
                    *(LAS f32x4*)(sb + 192 + c0) = (f32x4){kp[0], kp[1], kp[2], kp[3]}; *(LAS f32x4*)(sb + 192 + c0 + 4) = (f32x4){kp[4], kp[5], kp[6], kp[7]};
                    *(LAS f32x4*)(sb + 256 + c0) = (f32x4){wr[0], wr[1], wr[2], wr[3]}; *(LAS f32x4*)(sb + 256 + c0 + 4) = (f32x4){wr[4], wr[5], wr[6], wr[7]};
                    *(LAS f32x4*)(sb + 320 + c0) = (f32x4){v[0], v[1], v[2], v[3]}; *(LAS f32x4*)(sb + 320 + c0 + 4) = (f32x4){v[4], v[5], v[6], v[7]};
                    if ((lt & 7) == 0) { *(LAS f32x2*)(sb + 384) = (f32x2){br, kr}; if (d == 0 && (R == 2 || half == 0)) BONUS[m * 16 + h] = bon; }
                }
                if (ti >= 2) {
                    const int tj = ti - 2; const int js = tj * TT + st, t = d ? T - 1 - js : js;
                    const LAS float* ob = outb + (tj & 1) * RW_OUTF + st * 64 + c0; const f32x4 a = *(const LAS f32x4*)ob, b = *(const LAS f32x4*)(ob + 4);
                    h16x8 o; o[0] = (h16)a[0]; o[1] = (h16)a[1]; o[2] = (h16)a[2]; o[3] = (h16)a[3]; o[4] = (h16)b[0]; o[5] = (h16)b[1]; o[6] = (h16)b[2]; o[7] = (h16)b[3];
                    if (R == 2 || (c0 >> 5) == half) *(h16x8*)(OD + (size_t)t * 1024 + hc) = o;
                }
                __syncthreads();
            }
            {
                const int tj = ntiles - 1; const int js = tj * TT + st, t = d ? T - 1 - js : js;
                const LAS float* ob = outb + (tj & 1) * RW_OUTF + st * 64 + c0; const f32x4 a = *(const LAS f32x4*)ob, b = *(const LAS f32x4*)(ob + 4);
                h16x8 o; o[0] = (h16)a[0]; o[1] = (h16)a[1]; o[2] = (h16)a[2]; o[3] = (h16)a[3]; o[4] = (h16)b[0]; o[5] = (h16)b[1]; o[6] = (h16)b[2]; o[7] = (h16)b[3];
                if (R == 2 || (c0 >> 5) == half) *(h16x8*)(OD + (size_t)t * 1024 + hc) = o;
            }
        }
    }
}

__device__ void phase_rw_post(const Params& p) {
    const h16* P = (const h16*)(p.ws + OFF_P); const h16* OF = (const h16*)p.out; const h16* OB = OF + SZ_ARR / 2;
    const h16* GG = (const h16*)p.out + (size_t)3 * (SZ_ARR / 2); h16* MIX = (h16*)p.out; const float* BONUS = (const float*)(p.ws + OFF_BONUS);
    const int tid = opaque_tid(), hh = (tid & 127) >> 3, c0 = (tid & 7) * 8, hc = hh * 64 + c0;
    float gw[8], gb[8], mp[8], mn[8];
#pragma unroll
    for (int e = 0; e < 8; ++e) { gw[e] = p.gn_w[hc + e]; gb[e] = p.gn_b[hc + e]; mp[e] = p.mu_prev[2048 + hc + e]; mn[e] = p.mu_next[2048 + hc + e]; }
    struct LdR { h16x8 of, ob, gg, vc, vp, vn; float bon; };
    auto ld = [&](int m, LdR& x) {
        const int T = m < NPROMPT ? 4096 : 16384, t = m < NPROMPT ? (m & 4095) : (m - NPROMPT);
        const h16* ofp = m < NPROMPT ? OF + (size_t)m * 1024 : (const h16*)(p.ws + OFF_WUP) + (size_t)(m - NPROMPT) * 1024; const h16* obp = m < NPROMPT ? OB + (size_t)m * 1024 : (const h16*)(p.ws + OFF_WUP) + (size_t)16384 * 1024 + (size_t)(m - NPROMPT) * 1024;
        x.of = ldh8(ofp + hc); x.ob = ldh8(obp + hc); x.gg = ldh8(GG + (size_t)m * 1024 + hc);
        const h16* pv = P + (size_t)m * INC + 2048 + hc; x.vc = ldh8(pv); x.vp = t > 0 ? ldh8(pv - INC) : zeroh8(); x.vn = t < T - 1 ? ldh8(pv + INC) : zeroh8();
        x.bon = BONUS[(size_t)m * 16 + hh]; };
    auto fin = [&](int m, const LdR& x) {
        float o[8]; float sm = 0.f;
#pragma unroll
        for (int e = 0; e < 8; ++e) { o[e] = (float)x.of[e] + (float)x.ob[e]; sm += o[e]; }
        const float mu = red8(sm) * (1.f / 64.f); float vs = 0.f;
#pragma unroll
        for (int e = 0; e < 8; ++e) { o[e] -= mu; vs += o[e] * o[e]; }
        const float rstd = rsqrtf(red8(vs) * (1.f / 64.f) + 64e-5f);
        h16x8 r;
#pragma unroll
        for (int e = 0; e < 8; ++e) { const float z = (float)x.vc[e]; const float v = z + mp[e] * ((float)x.vp[e] - z) + mn[e] * ((float)x.vn[e] - z);
            r[e] = (h16)((o[e] * rstd * gw[e] + gb[e] + x.bon * v) * (float)x.gg[e]); }
        *(h16x8*)(MIX + (size_t)m * 1024 + hc) = r; };
    const int mstep = gridDim.x * 4;
    for (int m = blockIdx.x * 4 + (tid >> 7); m < MT; m += 2 * mstep) {
        LdR xa, xb; const bool hb = m + mstep < MT;
        ld(m, xa); if (hb) ld(m + mstep, xb);
        fin(m, xa); if (hb) fin(m + mstep, xb);
    }
}

constexpr int GD_STRIDE = 356, GD_INF = TT * GD_STRIDE, GD_OUTF = TT * 32;
constexpr int GDC = RWC;
__device__ __forceinline__ void conv_silu8(const h16* pc, bool hp, bool hn, const float* cw, float* out) {
    const h16x8 xc = ldh8(pc), xp = hp ? ldh8(pc - INC) : zeroh8(), xn = hn ? ldh8(pc + INC) : zeroh8();
    const f32x4 w0a = *(const f32x4*)cw, w0b = *(const f32x4*)(cw + 4), w1a = *(const f32x4*)(cw + 3072), w1b = *(const f32x4*)(cw + 3076), w2a = *(const f32x4*)(cw + 6144), w2b = *(const f32x4*)(cw + 6148);
#pragma unroll
    for (int e = 0; e < 8; ++e) { const float a0 = e < 4 ? w0a[e & 3] : w0b[e & 3], a1 = e < 4 ? w1a[e & 3] : w1b[e & 3], a2 = e < 4 ? w2a[e & 3] : w2b[e & 3];
        out[e] = fsilu((float)xp[e] * a0 + (float)xc[e] * a1 + (float)xn[e] * a2); }
}
__device__ __forceinline__ void gd_task(const Params& p, LAS unsigned char* shm, const int tid, const int s, const int d, const int h, const int rq) {
    LAS float* inb = (LAS float*)shm; LAS float* outb = inb + 2 * GD_INF;
    const h16* P = (const h16*)(p.ws + OFF_P);
    h16* OUTS = (h16*)(p.ws + OFF_XH);
    {
        const int T = s < 8 ? 4096 : 16384, base = s < 8 ? s * 4096 : NPROMPT, ntiles = T / TT;
        h16* OD = OUTS + (size_t)d * (SZ_ARR / 2);
        if (__builtin_amdgcn_readfirstlane(tid >> 6) < 4) {
            const int w = tid >> 6, l = tid & 63, j = l & 7, rs = l >> 3; const int row = w * 8 + rs;
            f32x2 sv[8];
#pragma unroll
            for (int e = 0; e < 8; ++e) sv[e] = (f32x2){0.f, 0.f};
            __syncthreads();
            for (int ti = 0; ti < ntiles; ++ti) {
                const LAS float* ib = inb + (ti & 1) * GD_INF; LAS float* ob = outb + (ti & 1) * GD_OUTF;
                LAS float* ow0 = j == 0 ? ob + row : outb + 2 * GD_OUTF + l; const int omask = j == 0 ? -1 : 0;
#pragma unroll 2
                for (int st = 0; st < TT; ++st) {
                    const LAS float* sb = ib + st * GD_STRIDE;
                    f32x2 kk[8], qq[8];
#pragma unroll
                    for (int e = 0; e < 4; ++e) { const f32x4 a = *(const LAS f32x4*)(sb + 20 * j + 4 * e), b = *(const LAS f32x4*)(sb + 160 + 20 * j + 4 * e);
                        kk[2 * e] = (f32x2){a[0], a[1]}; kk[2 * e + 1] = (f32x2){a[2], a[3]}; qq[2 * e] = (f32x2){b[0], b[1]}; qq[2 * e + 1] = (f32x2){b[2], b[3]}; }
                    const float v = sb[320 + row]; const f32x4 sc = *(const LAS f32x4*)(sb + 352); const float wdec = sc[0], cc = sc[1], kq = sc[2], beta = sc[3];
                    f32x2 pa = sv[0] * kk[0], px = sv[0] * qq[0], pa2 = sv[1] * kk[1], px2 = sv[1] * qq[1];
#pragma unroll
                    for (int e = 2; e < 8; e += 2) { pa += sv[e] * kk[e]; px += sv[e] * qq[e]; pa2 += sv[e + 1] * kk[e + 1]; px2 += sv[e + 1] * qq[e + 1]; }
                    pa += pa2; px += px2;
                    const float sa = red8(pa[0] + pa[1]), x = red8(px[0] + px[1]);
                    const float coef = beta * v - cc * sa; const float o = wdec * x + coef * kq;
                    const f32x2 wd2 = (f32x2){wdec, wdec}, cf2 = (f32x2){coef, coef};
#pragma unroll
                    for (int e = 0; e < 8; ++e) sv[e] = sv[e] * wd2 + cf2 * kk[e];
                    ow0[(st * 32) & omask] = o;
                }
                __syncthreads();
            }
        } else {
            const int lt = tid - 256, st = lt >> 3, jj = lt & 7;
            const int qcol = h * 128 + 16 * jj, kcol = 1024 + h * 128 + 16 * jj, vcol = 2048 + h * 128 + rq * 32 + 4 * jj;
            const float alog = -expf(p.a_log[d * 8 + h]), dtb = p.dt_bias[d * 8 + h];
            for (int ti = 0; ti <= ntiles; ++ti) {
                if (ti < ntiles) {
                    const int js = ti * TT + st, t = d ? T - 1 - js : js; const size_t m = (size_t)base + t;
                    const h16* pr = P + m * INC + GDC; const bool hp = t > 0, hn = t < T - 1;
                    const h16 bbv = pr[4096 + h], aav = pr[4104 + d * 8 + h];
                    float q[16], k[16];
                    conv_silu8(pr + qcol, hp, hn, p.gd_conv + qcol, q); conv_silu8(pr + qcol + 8, hp, hn, p.gd_conv + qcol + 8, q + 8);
                    conv_silu8(pr + kcol, hp, hn, p.gd_conv + kcol, k); conv_silu8(pr + kcol + 8, hp, hn, p.gd_conv + kcol + 8, k + 8);
                    float v[4];
                    { const h16* pc = pr + vcol; const h16x4 xc = *(const h16x4*)pc, xp = hp ? *(const h16x4*)(pc - INC) : (h16x4){(h16)0.f, (h16)0.f, (h16)0.f, (h16)0.f}, xn = hn ? *(const h16x4*)(pc + INC) : (h16x4){(h16)0.f, (h16)0.f, (h16)0.f, (h16)0.f};
                      const f32x4 a0 = *(const f32x4*)(p.gd_conv + vcol), a1 = *(const f32x4*)(p.gd_conv + 3072 + vcol), a2 = *(const f32x4*)(p.gd_conv + 6144 + vcol);
#pragma unroll
                      for (int e = 0; e < 4; ++e) v[e] = fsilu((float)xp[e] * a0[e] + (float)xc[e] * a1[e] + (float)xn[e] * a2[e]); }
                    float nq = 0.f, nk = 0.f;
#pragma unroll
                    for (int e = 0; e < 16; ++e) { nq += q[e] * q[e]; nk += k[e] * k[e]; }
                    nq = red8(nq); nk = red8(nk);
                    const float rq_ = rsqrtf(nq + 1e-6f) * 0.08838834764831845f, rk_ = rsqrtf(nk + 1e-6f);
                    float kq = 0.f;
#pragma unroll
                    for (int e = 0; e < 16; ++e) { q[e] *= rq_; k[e] *= rk_; kq += q[e] * k[e]; }
                    kq = red8(kq);
                    LAS float* sb = inb + (ti & 1) * GD_INF + st * GD_STRIDE;
#pragma unroll
                    for (int e = 0; e < 4; ++e) { *(LAS f32x4*)(sb + 20 * jj + 4 * e) = (f32x4){k[4 * e], k[4 * e + 1], k[4 * e + 2], k[4 * e + 3]};
                        *(LAS f32x4*)(sb + 160 + 20 * jj + 4 * e) = (f32x4){q[4 * e], q[4 * e + 1], q[4 * e + 2], q[4 * e + 3]}; }
                    *(LAS f32x4*)(sb + 320 + 4 * jj) = (f32x4){v[0], v[1], v[2], v[3]};
                    if (jj == 0) { const float beta = fsigmoid((float)bbv); const float ain = (float)aav;
                        const float g = alog * softplusf_(ain + dtb); const float wdec = __expf(g);
                        *(LAS f32x4*)(sb + 352) = (f32x4){wdec, wdec * beta, kq, beta}; }
                }
                if (ti >= 2) {
                    const int tj = ti - 2; const int js = tj * TT + st, t = d ? T - 1 - js : js; const size_t m = (size_t)base + t;
                    const f32x4 a = *(const LAS f32x4*)(outb + (tj & 1) * GD_OUTF + st * 32 + 4 * jj);
                    h16x4 o; o[0] = (h16)a[0]; o[1] = (h16)a[1]; o[2] = (h16)a[2]; o[3] = (h16)a[3];
                    *(h16x4*)(OD + m * 1024 + h * 128 + rq * 32 + 4 * jj) = o;
                }
                __syncthreads();
            }
            {
                const int tj = ntiles - 1; const int js = tj * TT + st, t = d ? T - 1 - js : js; const size_t m = (size_t)base + t;
                const f32x4 a = *(const LAS f32x4*)(outb + (tj & 1) * GD_OUTF + st * 32 + 4 * jj);
                h16x4 o; o[0] = (h16)a[0]; o[1] = (h16)a[1]; o[2] = (h16)a[2]; o[3] = (h16)a[3];
                *(h16x4*)(OD + m * 1024 + h * 128 + rq * 32 + 4 * jj) = o;
            }
        }
    }
}

constexpr int GD_KS = 136;
constexpr int GD_VS = 132;
constexpr int GD_QH = 32 * GD_KS * 2, GD_V = 2 * GD_QH, GD_SC = GD_V + 32 * GD_VS * 4, GD_BUF = GD_SC + 512;
constexpr int GD_OUT0 = 2 * GD_BUF, GD_OUTB = 32 * GD_VS * 4, GD_WV0 = GD_OUT0 + 2 * GD_OUTB, GD_WVB = 2048 + 64, GD_CW0 = GD_WV0 + 8 * GD_WVB;
constexpr int LDS_TASK_OFF = 139264;
static_assert(GD_CW0 + 3 * 384 * 4 <= LDS_TASK_OFF, "gdn lds map");
template <int CTRL> __device__ __forceinline__ float dpp_shr0(float x) { return __builtin_bit_cast(float, __builtin_amdgcn_update_dpp(0, __builtin_bit_cast(int, x), CTRL, 0xF, 0xF, true)); }
__device__ __forceinline__ void gd_mfma_task(const Params& p, LAS unsigned char* shm, const int tid, const int s, const int d, const int h) {
    const h16* P = (const h16*)(p.ws + OFF_P);
    h16* OD = (h16*)(p.ws + OFF_XH) + (size_t)d * (SZ_ARR / 2);
    const int T = s < 8 ? 4096 : 16384, base = s < 8 ? s * 4096 : NPROMPT, ntiles = T / 32;
    const int wv = __builtin_amdgcn_readfirstlane(tid >> 6);
    LAS float* CW = (LAS float*)(shm + GD_CW0);
    LAS float* GCW = (LAS float*)(shm + GD_WV0 + wv * GD_WVB); LAS float* HDW = GCW + 16;
    for (int i = tid; i < 1152; i += 512) { const int tap = i / 384, c = i - tap * 384; const int part = c >> 7, cc = c & 127; CW[i] = p.gd_conv[(size_t)tap * 3072 + part * 1024 + h * 128 + cc]; }
    const float alog = -expf(p.a_log[d * 8 + h]), dtb = p.dt_bias[d * 8 + h];
    f32x4 acc[8];
#pragma unroll
    for (int t = 0; t < 8; ++t) acc[t] = (f32x4){0.f, 0.f, 0.f, 0.f};
    struct Raw { h16x8 q[3], k[3], v[3]; h16 b, a; };
    auto issue = [&](int ti, Raw& x) {
        const int tid2 = opaque_tid(), lst = tid2 >> 4, c8 = (tid2 & 15) * 8;
        const int js = ti * 32 + lst, t = d ? T - 1 - js : js; const size_t m = (size_t)base + t;
        const h16* pr = P + m * INC + GDC + h * 128 + c8; const bool hp = t > 0, hn = t < T - 1;
        x.q[1] = ldh8(pr); x.q[0] = hp ? ldh8(pr - INC) : zeroh8(); x.q[2] = hn ? ldh8(pr + INC) : zeroh8();
        x.k[1] = ldh8(pr + 1024); x.k[0] = hp ? ldh8(pr + 1024 - INC) : zeroh8(); x.k[2] = hn ? ldh8(pr + 1024 + INC) : zeroh8();
        x.v[1] = ldh8(pr + 2048); x.v[0] = hp ? ldh8(pr + 2048 - INC) : zeroh8(); x.v[2] = hn ? ldh8(pr + 2048 + INC) : zeroh8();
        const h16* ps = P + m * INC + GDC + 4096; x.b = ps[h]; x.a = ps[8 + d * 8 + h]; };
    auto process = [&](int ti, const Raw& x) {
        const int tid2 = opaque_tid(), lst = tid2 >> 4, sl = tid2 & 15, c8 = sl * 8;
        LAS unsigned char* ib = shm + (ti & 1) * GD_BUF;
        float qv[8], kv[8], vv[8]; float nq = 0.f, nk = 0.f;
#pragma unroll
        for (int hf = 0; hf < 2; ++hf) {
            const f32x4 q0 = *(const LAS f32x4*)(CW + c8 + 4 * hf), q1 = *(const LAS f32x4*)(CW + 384 + c8 + 4 * hf), q2 = *(const LAS f32x4*)(CW + 768 + c8 + 4 * hf);
            const f32x4 k0 = *(const LAS f32x4*)(CW + 128 + c8 + 4 * hf), k1 = *(const LAS f32x4*)(CW + 512 + c8 + 4 * hf), k2 = *(const LAS f32x4*)(CW + 896 + c8 + 4 * hf);
            const f32x4 v0 = *(const LAS f32x4*)(CW + 256 + c8 + 4 * hf), v1 = *(const LAS f32x4*)(CW + 640 + c8 + 4 * hf), v2 = *(const LAS f32x4*)(CW + 1024 + c8 + 4 * hf);
#pragma unroll
            for (int e = 0; e < 4; ++e) { const int c = 4 * hf + e;
                qv[c] = fsilu((float)x.q[0][c] * q0[e] + (float)x.q[1][c] * q1[e] + (float)x.q[2][c] * q2[e]);
                kv[c] = fsilu((float)x.k[0][c] * k0[e] + (float)x.k[1][c] * k1[e] + (float)x.k[2][c] * k2[e]);
                vv[c] = fsilu((float)x.v[0][c] * v0[e] + (float)x.v[1][c] * v1[e] + (float)x.v[2][c] * v2[e]);
                nq += qv[c] * qv[c]; nk += kv[c] * kv[c]; } }
        nq = red16(nq); nk = red16(nk);
        const float rq_ = rsqrtf(nq + 1e-6f) * 0.08838834764831845f, rk_ = rsqrtf(nk + 1e-6f);
        const float beta = fsigmoid((float)x.b);
        h16x8 kh, qh; f32x4 va, vb;
#pragma unroll
        for (int c = 0; c < 8; ++c) { kh[c] = (h16)(kv[c] * rk_); qh[c] = (h16)(qv[c] * rq_); }
        va = (f32x4){vv[0] * beta, vv[1] * beta, vv[2] * beta, vv[3] * beta}; vb = (f32x4){vv[4] * beta, vv[5] * beta, vv[6] * beta, vv[7] * beta};
        *(LAS h16x8*)(ib + (lst * GD_KS + c8) * 2) = kh; *(LAS h16x8*)(ib + GD_QH + (lst * GD_KS + c8) * 2) = qh;
        *(LAS f32x4*)(ib + GD_V + (lst * GD_VS + c8) * 4) = va; *(LAS f32x4*)(ib + GD_V + (lst * GD_VS + c8 + 4) * 4) = vb;
        if (sl == 0) { const float g = alog * softplusf_((float)x.a + dtb); const float wd = __expf(g); *(LAS f32x4*)(ib + GD_SC + lst * 16) = (f32x4){g, wd, wd * beta, 0.f}; } };
    auto flush = [&](int ti) {
        const int tid2 = opaque_tid(), lst = tid2 >> 4, c8 = (tid2 & 15) * 8;
        const int js = ti * 32 + lst, t = d ? T - 1 - js : js; const size_t m = (size_t)base + t;
        const LAS float* ob = (const LAS float*)(shm + GD_OUT0 + (ti & 1) * GD_OUTB) + lst * GD_VS + c8; const f32x4 a = *(const LAS f32x4*)ob, b = *(const LAS f32x4*)(ob + 4);
        h16x8 o; o[0] = (h16)a[0]; o[1] = (h16)a[1]; o[2] = (h16)a[2]; o[3] = (h16)a[3]; o[4] = (h16)b[0]; o[5] = (h16)b[1]; o[6] = (h16)b[2]; o[7] = (h16)b[3];
        *(h16x8*)(OD + m * 1024 + h * 128 + c8) = o; };
    auto chunk = [&](int cc, const LAS unsigned char* ib, LAS float* ob) {
        const int lane2 = opaque_tid() & 63, r = lane2 & 15, q = lane2 >> 4;
        const LAS h16* Kh = (const LAS h16*)ib; const LAS h16* Qh = (const LAS h16*)(ib + GD_QH); const LAS float* Vb = (const LAS float*)(ib + GD_V); const LAS float* SC = (const LAS float*)(ib + GD_SC);
        const int s0 = cc * 16;
        h16x8 kf[4], qf[4];
#pragma unroll
        for (int t = 0; t < 4; ++t) {
            const h16x4 k0 = *(const LAS h16x4*)(Kh + (s0 + r) * GD_KS + 32 * t + 4 * q), k1 = *(const LAS h16x4*)(Kh + (s0 + r) * GD_KS + 32 * t + 16 + 4 * q);
            const h16x4 q0 = *(const LAS h16x4*)(Qh + (s0 + r) * GD_KS + 32 * t + 4 * q), q1 = *(const LAS h16x4*)(Qh + (s0 + r) * GD_KS + 32 * t + 16 + 4 * q);
            kf[t][0] = k0[0]; kf[t][1] = k0[1]; kf[t][2] = k0[2]; kf[t][3] = k0[3]; kf[t][4] = k1[0]; kf[t][5] = k1[1]; kf[t][6] = k1[2]; kf[t][7] = k1[3];
            qf[t][0] = q0[0]; qf[t][1] = q0[1]; qf[t][2] = q0[2]; qf[t][3] = q0[3]; qf[t][4] = q1[0]; qf[t][5] = q1[1]; qf[t][6] = q1[2]; qf[t][7] = q1[3]; }
        f32x4 G = (f32x4){0.f, 0.f, 0.f, 0.f}, H = G;
#pragma unroll
        for (int t = 0; t < 4; ++t) { G = __builtin_amdgcn_mfma_f32_16x16x32_f16(kf[t], kf[t], G, 0, 0, 0); H = __builtin_amdgcn_mfma_f32_16x16x32_f16(kf[t], qf[t], H, 0, 0, 0); }
        const f32x4 scr = *(const LAS f32x4*)(SC + (s0 + r) * 4);
        float gc = scr[0]; gc += dpp_shr0<0x111>(gc); gc += dpp_shr0<0x112>(gc); gc += dpp_shr0<0x114>(gc); gc += dpp_shr0<0x118>(gc);
        const float gce_r = gc - scr[0], wb_r = scr[2];
        GCW[r] = gc;
        HDW[(r >> 2) == q ? r : 32 + lane2] = H[r & 3];
        const f32x4 gca = *(const LAS f32x4*)(GCW + 4 * q), hda = *(const LAS f32x4*)(HDW + 4 * q); const float gc15 = GCW[15];
        f32x4 w_a, wb_a, dm_a, e_a, gce4;
#pragma unroll
        for (int e = 0; e < 4; ++e) { const f32x4 sa = *(const LAS f32x4*)(SC + (s0 + 4 * q + e) * 4); w_a[e] = sa[1]; wb_a[e] = sa[2]; gce4[e] = gca[e] - sa[0]; dm_a[e] = __expf(gce4[e]); e_a[e] = __expf(gc15 - gca[e]); }
        f32x4 Lm, Lt, HRt;
#pragma unroll
        for (int e = 0; e < 4; ++e) { const int aa = 4 * q + e;
            const float gce_a = gce4[e];
            const float fu = __expf(fminf(gce_r - gca[e], 0.f));
            const float fl = __expf(fminf(gce_a - gc, 0.f));
            Lt[e] = aa < r ? wb_r * G[e] * fu : 0.f;
            Lm[e] = r < aa ? wb_a[e] * G[e] * fl : 0.f;
            HRt[e] = aa < r ? H[e] * fu : 0.f; }
        auto pk = [](const f32x4 x) { h16x8 o; o[0] = (h16)x[0]; o[1] = (h16)x[1]; o[2] = (h16)x[2]; o[3] = (h16)x[3]; o[4] = (h16)0.f; o[5] = (h16)0.f; o[6] = (h16)0.f; o[7] = (h16)0.f; return o; };
        auto mm = [&](const f32x4 X, const f32x4 Yb, const f32x4 C) { return __builtin_amdgcn_mfma_f32_16x16x32_f16(pk(X), pk(Yb), C, 0, 0, 0); };
        const f32x4 zero4 = (f32x4){0.f, 0.f, 0.f, 0.f};
        const f32x4 L2t = mm(Lm, Lt, zero4), L2 = mm(Lt, Lm, zero4);
        const f32x4 L4t = mm(L2, L2t, zero4), L4 = mm(L2t, L2, zero4);
        const f32x4 L8t = mm(L4, L4t, zero4);
        f32x4 Y = zero4, Z = zero4;
#pragma unroll
        for (int t = 0; t < 4; ++t) {
            const f32x4 a0 = acc[2 * t], a1 = acc[2 * t + 1]; h16x8 sb;
            sb[0] = (h16)a0[0]; sb[1] = (h16)a0[1]; sb[2] = (h16)a0[2]; sb[3] = (h16)a0[3]; sb[4] = (h16)a1[0]; sb[5] = (h16)a1[1]; sb[6] = (h16)a1[2]; sb[7] = (h16)a1[3];
            Y = __builtin_amdgcn_mfma_f32_16x16x32_f16(kf[t], sb, Y, 0, 0, 0); Z = __builtin_amdgcn_mfma_f32_16x16x32_f16(qf[t], sb, Z, 0, 0, 0); }
        f32x4 rhs;
#pragma unroll
        for (int e = 0; e < 4; ++e) rhs[e] = Vb[(s0 + 4 * q + e) * GD_VS + wv * 16 + r] - wb_a[e] * dm_a[e] * Y[e];
        const f32x4 r1 = mm(L8t, rhs, rhs), r2 = mm(L4t, r1, r1), r3 = mm(L2t, r2, r2);
        const f32x4 cv = mm(-Lt, r3, r3);
        f32x4 xz;
#pragma unroll
        for (int e = 0; e < 4; ++e) xz[e] = dm_a[e] * Z[e];
        const f32x4 xx = mm(HRt, cv, xz);
#pragma unroll
        for (int e = 0; e < 4; ++e) ob[(s0 + 4 * q + e) * GD_VS + wv * 16 + r] = w_a[e] * xx[e] + cv[e] * hda[e];
        const float d16 = __expf(gc15);
#pragma unroll
        for (int t = 0; t < 8; ++t) acc[t] *= d16;
        const h16x8 cb = pk(cv * e_a);
#pragma unroll
        for (int t = 0; t < 8; ++t) { h16x8 ka;
#pragma unroll
            for (int e = 0; e < 4; ++e) { ka[e] = Kh[(s0 + 4 * q + e) * GD_KS + 16 * t + r]; ka[4 + e] = (h16)0.f; }
            acc[t] = __builtin_amdgcn_mfma_f32_16x16x32_f16(ka, cb, acc[t], 0, 0, 0); }
    };
    __syncthreads();
    Raw raw;
    issue(0, raw); process(0, raw);
    __syncthreads();
    for (int ti = 0; ti < ntiles; ++ti) {
        const bool more = ti + 1 < ntiles;
        if (more) issue(ti + 1, raw);
        const LAS unsigned char* ib = shm + (ti & 1) * GD_BUF; LAS float* ob = (LAS float*)(shm + GD_OUT0 + (ti & 1) * GD_OUTB);
        chunk(0, ib, ob); chunk(1, ib, ob);
        if (more) process(ti + 1, raw);
        __syncthreads();
        flush(ti);
    }
}

__device__ void phase_scans(const Params& p, LAS unsigned char* shm, int cidx) {
    LAS int* s_task = (LAS int*)(shm + LDS_TASK_OFF);
    unsigned* ctr = (unsigned*)(p.ws + OFF_CTR) + cidx;
    for (;;) {
        const int tid = opaque_tid();
        if (tid == 0) *s_task = (int)atomicAdd(ctr, 1u);
        __syncthreads();
        const int task = __builtin_amdgcn_readfirstlane(*s_task);
        __syncthreads();
        if (task >= 512) break;
        if (task < 64) gd_task(p, shm, tid, 8, task >> 5, (task >> 2) & 7, task & 3);
        else if (task < 128) { const int u = task - 64; rw_task<1>(p, shm, tid, 8, u >> 5, (u >> 1) & 15, u & 1); }
        else if (task < 256) { const int u = task - 128; gd_mfma_task(p, shm, tid, u >> 4, (u >> 3) & 1, u & 7); }
        else { const int u = task - 256; rw_task<2>(p, shm, tid, u >> 5, (u >> 4) & 1, u & 15, 0); }
        __syncthreads();
    }
}


__device__ void phase_gd_post(const Params& p) {
    const h16* P = (const h16*)(p.ws + OFF_P); const h16* OF = (const h16*)(p.ws + OFF_XH); const h16* OB = OF + SZ_ARR / 2; h16* MIX = (h16*)(p.ws + OFF_XH);
    const int tid = opaque_tid(), hh = (tid & 63) >> 3, c0 = (tid & 7) * 16, hc = hh * 128 + c0;
    float nw[16];
#pragma unroll
    for (int e = 0; e < 16; ++e) nw[e] = p.gd_norm[c0 + e];
    for (int m = blockIdx.x * 8 + (tid >> 6); m < MT; m += gridDim.x * 8) {
        float o[16]; float ss = 0.f;
#pragma unroll
        for (int hlf = 0; hlf < 2; ++hlf) { const h16x8 of = ldh8(OF + (size_t)m * 1024 + hc + 8 * hlf), ob = ldh8(OB + (size_t)m * 1024 + hc + 8 * hlf);
#pragma unroll
            for (int e = 0; e < 8; ++e) { o[8 * hlf + e] = (float)of[e] + (float)ob[e]; ss += o[8 * hlf + e] * o[8 * hlf + e]; } }
        const float rr = rsqrtf(red8(ss) * (1.f / 128.f) + 1e-6f);
#pragma unroll
        for (int hlf = 0; hlf < 2; ++hlf) { const h16x8 z = ldh8(P + (size_t)m * INC + GDC + 3072 + hc + 8 * hlf); h16x8 r;
#pragma unroll
            for (int e = 0; e < 8; ++e) r[e] = (h16)(o[8 * hlf + e] * rr * nw[8 * hlf + e] * fsilu((float)z[e]));
            *(h16x8*)(MIX + (size_t)m * 1024 + hc + 8 * hlf) = r; }
    }
}

__device__ void phase_ln(const h16* __restrict__ in, float* __restrict__ out32, h16* __restrict__ out16, const float* __restrict__ g, const float* __restrict__ b) {
    const int tid = opaque_tid(), lane = tid & 63, wv = tid >> 6;
    const int mstep = gridDim.x * 8; h16x4 nx[8];
    { const int m0 = blockIdx.x * 8 + wv; if (m0 < MT) { const h16* rp = in + (size_t)m0 * DM;
#pragma unroll
        for (int i = 0; i < 8; ++i) nx[i] = *(const h16x4*)(rp + i * 256 + lane * 4); } }
    for (int m = blockIdx.x * 8 + wv; m < MT; m += mstep) {
        f32x4 x[8]; float s = 0.f;
#pragma unroll
        for (int i = 0; i < 8; ++i) { const h16x4 hv = nx[i]; x[i] = (f32x4){(float)hv[0], (float)hv[1], (float)hv[2], (float)hv[3]}; s += x[i][0] + x[i][1] + x[i][2] + x[i][3]; }
        if (m + mstep < MT) { const h16* rp = in + (size_t)(m + mstep) * DM;
#pragma unroll
            for (int i = 0; i < 8; ++i) nx[i] = *(const h16x4*)(rp + i * 256 + lane * 4); }
        const float mu = wave_sum(s) * (1.f / DM); float vs = 0.f;
#pragma unroll
        for (int i = 0; i < 8; ++i) { x[i] -= mu; vs += x[i][0] * x[i][0] + x[i][1] * x[i][1] + x[i][2] * x[i][2] + x[i][3] * x[i][3]; }
        const float rstd = rsqrtf(wave_sum(vs) * (1.f / DM) + 1e-5f);
#pragma unroll
        for (int i = 0; i < 8; ++i) { const int c = i * 256 + lane * 4; const f32x4 gg = *(const f32x4*)(g + c), bb = *(const f32x4*)(b + c); const f32x4 y = x[i] * rstd * gg + bb;
            if (out32) *(f32x4*)(out32 + (size_t)m * DM + c) = y;
            if (out16) { h16x4 hv; hv[0] = (h16)y[0]; hv[1] = (h16)y[1]; hv[2] = (h16)y[2]; hv[3] = (h16)y[3]; *(h16x4*)(out16 + (size_t)m * DM + c) = hv; } }
    }
}

__device__ void phase_convact(const Params& p, int grp) {
    const h16* U = (const h16*)p.out; h16* ACT = (h16*)(p.ws + OFF_ACT);
    const int T = grp < 2 ? 4096 : 16384; constexpr int RB = 16, NC8 = DFF / 8;
    const int nitems = (GROWS / RB) * NC8;
    const int tid = opaque_tid();
    for (int it = blockIdx.x * 512 + tid; it < nitems; it += gridDim.x * 512) {
        const int rb = it / NC8, c = (it - rb * NC8) * 8; const int r0 = rb * RB;
        float wg[3][8], wv[3][8];
#pragma unroll
        for (int i = 0; i < 3; ++i)
#pragma unroll
            for (int e = 0; e < 8; ++e) { wg[i][e] = p.ffn_conv[(size_t)i * DFF2 + c + e]; wv[i][e] = p.ffn_conv[(size_t)i * DFF2 + DFF + c + e]; }
#pragma unroll 1
        for (int hb = 0; hb < RB / 8; ++hb) {
            const int rb0 = r0 + 8 * hb; const bool hp = (rb0 & (T - 1)) != 0, hn = ((rb0 + 7) & (T - 1)) != T - 1;
            h16x8 gr[10], vr[10];
#pragma unroll
            for (int k = 0; k < 10; ++k) { const bool ok = (k == 0) ? hp : ((k == 9) ? hn : true); const size_t rr = (size_t)(rb0 - 1 + k);
                if (ok) { gr[k] = ldh8(U + rr * DFF2 + c); vr[k] = ldh8(U + rr * DFF2 + DFF + c); } else { gr[k] = zeroh8(); vr[k] = zeroh8(); } }
#pragma unroll
            for (int i = 0; i < 8; ++i) { h16x8 o;
#pragma unroll
                for (int e = 0; e < 8; ++e) { const float gte = (float)gr[i][e] * wg[0][e] + (float)gr[i + 1][e] * wg[1][e] + (float)gr[i + 2][e] * wg[2][e];
                    const float val = (float)vr[i][e] * wv[0][e] + (float)vr[i + 1][e] * wv[1][e] + (float)vr[i + 2][e] * wv[2][e]; o[e] = (h16)(fsilu(gte) * val); }
                *(h16x8*)(ACT + (size_t)(rb0 + i) * DFF + c) = o; }
        }
    }
}

#define XB_TMO      128
#define XB_XCNT(j)  (256  + 64 * (j))
#define XB_XSUB(j)  (1280 + 64 * (j))
#define XB_XGEN(j)  (2304 + 64 * (j))
#define XB_TOP      3328
#define XB_TOPGEN   3392
#define XCD_BAR_WORDS 3456
#define XB_SPIN_CAP (1u << 22)
constexpr size_t OFF_BAR = OFF_CTR + 1024;
static_assert(1024 + XCD_BAR_WORDS * 4 <= SZ_CTR, "barrier words");
__device__ __forceinline__ unsigned xb_ld(unsigned* p)              { return __hip_atomic_load(p, __ATOMIC_RELAXED, __HIP_MEMORY_SCOPE_AGENT); }
__device__ __forceinline__ unsigned xb_add(unsigned* p, unsigned v) { return __hip_atomic_fetch_add(p, v, __ATOMIC_RELAXED, __HIP_MEMORY_SCOPE_AGENT); }
__device__ __forceinline__ unsigned xb_xcc_id() { return (unsigned)__builtin_amdgcn_s_getreg((3 << 11) | 20) & 0xFu; }
#define XB_SPIN(cond, bar) do { unsigned _sp = 0; while (cond) { __builtin_amdgcn_s_sleep(1); \
    if ((++_sp & 255u) == 0u) { if (xb_ld(&(bar)[XB_TMO])) break; if (_sp > XB_SPIN_CAP) { atomicAdd(&(bar)[XB_TMO], 1u); break; } } } } while (0)
struct XcdBarrier { unsigned* bar; unsigned x; volatile LAS unsigned* st; };
__device__ __forceinline__ XcdBarrier xcd_barrier_post(unsigned* bar, volatile LAS unsigned* st) {
    XcdBarrier b; b.bar = bar; b.x = xb_xcc_id(); b.st = st;
    if (threadIdx.x == 0) (void)xb_add(&bar[XB_XCNT(b.x)], 1u);
    return b;
}
__device__ __forceinline__ void xcd_barrier_complete(unsigned* bar, unsigned x, unsigned& nloc, unsigned& nx) {
    const unsigned G = gridDim.x * gridDim.y * gridDim.z;
    unsigned sum, cnt, mine, sp = 0u;
    for (;;) {
        sum = 0u; cnt = 0u; mine = 0u;
#pragma unroll
        for (unsigned j = 0; j < 16; ++j) { const unsigned c = xb_ld(&bar[XB_XCNT(j)]); sum += c; cnt += (c > 0u) ? 1u : 0u; mine = (j == x) ? c : mine; }
        if (sum == G) break;
        __builtin_amdgcn_s_sleep(1);
        if ((++sp & 255u) == 0u) { if (xb_ld(&bar[XB_TMO])) break; if (sp > XB_SPIN_CAP) { atomicAdd(&bar[XB_TMO], 1u); break; } }
    }
    nloc = mine > 0u ? mine : 1u; nx = cnt > 0u ? cnt : 1u;
}
__device__ __forceinline__ void xcd_barrier(const XcdBarrier& b) {
    asm volatile("s_waitcnt vmcnt(0)" ::: "memory");
    __syncthreads();
    if (threadIdx.x == 0) {
        unsigned* bar = b.bar;
        __builtin_amdgcn_s_waitcnt(0);
        unsigned nloc = b.st[0], nx = b.st[1];
        if (nloc == 0u) { xcd_barrier_complete(bar, b.x, nloc, nx); b.st[0] = nloc; b.st[1] = nx; }
        const unsigned old = xb_add(&bar[XB_XSUB(b.x)], 1u);
        const unsigned gen = old / nloc;
        if (old + 1u == (gen + 1u) * nloc) {
            __builtin_amdgcn_fence(__ATOMIC_RELEASE, "agent");
            asm volatile("s_waitcnt vmcnt(0)" ::: "memory");
            const unsigned og = xb_add(&bar[XB_TOP], 1u);
            const unsigned tg = og / nx;
            if (og + 1u == (tg + 1u) * nx) xb_add(&bar[XB_TOPGEN], 1u);
            else XB_SPIN(xb_ld(&bar[XB_TOPGEN]) == tg, bar);
            __builtin_amdgcn_fence(__ATOMIC_ACQUIRE, "agent");
            xb_add(&bar[XB_XGEN(b.x)], 1u);
            asm volatile("s_waitcnt vmcnt(0)" ::: "memory");
        } else {
            XB_SPIN(xb_ld(&bar[XB_XGEN(b.x)]) == gen, bar);
            __builtin_amdgcn_fence(__ATOMIC_ACQUIRE, "agent");
            asm volatile("s_waitcnt vmcnt(0)" ::: "memory");
        }
    }
    __syncthreads();
}

constexpr int NPH = 18;
__device__ __forceinline__ Gemm mkgemm(const h16* A, const h16* Bt, int M, int N, int K) { return Gemm{A, Bt, M, N, K, A, K / BK, K}; }
__global__ __launch_bounds__(512, 2) void mk_kernel(Params p, int lo, int hi) {
    extern __shared__ __attribute__((aligned(16))) unsigned char shm_raw[];
    LAS unsigned char* shm = (LAS unsigned char*)shm_raw;
    unsigned char* ws = p.ws;
    volatile LAS unsigned* xst = (volatile LAS unsigned*)(shm + LDS_TASK_OFF + 64);
    if (threadIdx.x == 0) { xst[0] = 0u; xst[1] = 0u; }
    __syncthreads();
    const XcdBarrier xb = xcd_barrier_post((unsigned*)(ws + OFF_BAR), xst);
    for (int ph = lo; ph < hi; ++ph) {
        if (ph == lo + 1) cg::this_grid().sync();
        else if (ph > lo) xcd_barrier(xb);
        const int nrep = (ph == REP_PH) ? REP_N : 1;
        for (int rep = 0; rep < nrep; ++rep) {
        int kind = -1, ngemm = 1; Gemm g{}; EpiH16 eh{}; EpiRes er{};
        if (ph == 0) phase_convert(p, shm, 0);
        else if (ph == 1) { kind = 0; g = mkgemm((const h16*)(ws + OFF_XH), (const h16*)(ws + OFF_WIN), MT, INCP, DM); eh = EpiH16{(h16*)(ws + OFF_P), INC, INC, 30, 0}; }
        else if (ph == 2) phase_lora_prep(p);
        else if (ph == 3) { kind = 0; ngemm = 2; }
        else if (ph == 4) phase_scans(p, shm, 4 + 16 * rep);
        else if (ph == 5) { phase_rw_post(p); phase_gd_post(p); }
        else if (ph == 6) { kind = 1; g = Gemm{(const h16*)p.out, (const h16*)(ws + OFF_WOUT), MT, DM, DM, (const h16*)(ws + OFF_XH), 16, 1024}; er = EpiRes{(h16*)(ws + OFF_P), p.xp, p.xs, NPROMPT, nullptr}; }
        else if (ph == 7) { phase_convert(p, shm, 1); phase_ln((const h16*)(ws + OFF_P), nullptr, (h16*)(ws + OFF_XH), p.ln1g, p.ln1b); }
        else if (ph < 17) { const int grp = (ph - 8) / 3, sub = (ph - 8) % 3;
            if (sub == 0) { kind = 0; g = mkgemm((const h16*)(ws + OFF_XH) + (size_t)grp * GROWS * DM, (const h16*)(ws + OFF_WUP), GROWS, DFF2, DM); eh = EpiH16{(h16*)p.out, DFF2, DFF2, 44, 0}; }
            else if (sub == 1) phase_convact(p, grp);
            else { kind = 1; h16* hb = (h16*)(ws + OFF_P) + (size_t)grp * GROWS * DM; g = mkgemm((const h16*)(ws + OFF_ACT), (const h16*)(ws + OFF_WDN), GROWS, DM, DFF); er = EpiRes{hb, nullptr, nullptr, 1 << 30, (const h16*)(ws + OFF_XH) + (size_t)grp * GROWS * DM}; } }
        else phase_ln((const h16*)(ws + OFF_P), p.out, nullptr, p.ln2g, p.ln2b);
        if (kind >= 0) for (int gi = 0; gi < ngemm; ++gi) {
            if (ph == 3) { const h16* lin = (const h16*)(ws + OFF_XH) + 256 * gi; const h16* lt = (const h16*)(ws + OFF_LORAT) + (size_t)3072 * 256 * gi;
                g = Gemm{lin, lt, MT, gi == 0 ? 3072 : 1024, 256, lin, 4, 512}; eh = EpiH16{(h16*)p.out + (size_t)3 * (SZ_ARR / 2) * gi, 1024, 1024, 4, SZ_ARR / 2}; }
            StaticOrder S; S.init(g.M, g.N, (int)gridDim.x, (int)blockIdx.x);
            if (kind == 0) gemm_phase<EpiH16>(shm, g, S, eh); else gemm_phase<EpiRes>(shm, g, S, er); }
        }
    }
}

extern "C" void kernel_launch(void* const* d_in, const int* in_sizes, int n_in, void* d_out, int out_size, void* d_ws, size_t ws_size, hipStream_t stream) {
    Params p{};
    const float** f = (const float**)&p;
    for (int i = 0; i < 27; ++i) f[i] = (const float*)d_in[i];
    p.out = (float*)d_out; p.ws = (unsigned char*)d_ws;
    static int grid = 0;
    if (!grid) {
        hipFuncSetAttribute((const void*)mk_kernel, hipFuncAttributeMaxDynamicSharedMemorySize, LDS_TOTAL);
        int dev = 0, cus = 0, per = 0; hipGetDevice(&dev); hipDeviceGetAttribute(&cus, hipDeviceAttributeMultiprocessorCount, dev);
        hipOccupancyMaxActiveBlocksPerMultiprocessor(&per, mk_kernel, 512, LDS_TOTAL);
        if (per < 1) per = 1;
        grid = cus;
    }
    (void)hipMemsetAsync((unsigned char*)d_ws + OFF_CTR, 0, SZ_CTR, stream);
#if ONE_LAUNCH
    int lo = 0, hi = NPH; void* args[] = {&p, &lo, &hi};
    hipError_t e = hipLaunchCooperativeKernel((void*)mk_kernel, dim3(grid), dim3(512), args, LDS_TOTAL, stream);
    if (e != hipSuccess) fprintf(stderr, "cooperative launch failed: %s\n", hipGetErrorString(e));
#else
    for (int ph = 0; ph < NPH; ++ph) hipLaunchKernelGGL(mk_kernel, dim3(grid), dim3(512), LDS_TOTAL, stream, p, ph, ph + 1);
#endif
}
```
